# Optimizing an MI355X kernel written in HIP

```python
import jax, jax.numpy as jnp
from jax import lax
import numpy as np

D_MODEL = 1024
BATCH = 16
SEQ = 2048
DEPTH = 2

HEAD_DIM = 64
N_HEADS_SB = 8
N_HEADS_RET = 8
N_HEADS_SWA = 16
N_KV_SWA = 4
WINDOW = 128
Q_BLOCK = 128
RET_CHUNK = 128
ROPE_THETA = 10000.0
N_GROUPS = 4
EXPERTS_PER_GROUP = 8
N_EXPERTS = N_GROUPS * EXPERTS_PER_GROUP
TOP_K_IN_GROUP = 2
D_EXPERT = 512
MOE_BLOCK = 256
EPS = 1e-6

W_SB = N_HEADS_SB * HEAD_DIM
W_RET = N_HEADS_RET * HEAD_DIM
IN_AB = 3 * W_SB + 4 * W_RET
OUT_AB = W_SB + W_RET
W_Q_SWA = N_HEADS_SWA * HEAD_DIM
W_KV_SWA = N_KV_SWA * HEAD_DIM
IN_C = W_Q_SWA + 2 * W_KV_SWA
N_EVEN = (DEPTH + 1) // 2
N_ODD = DEPTH // 2

kernel_name = 'hybrid_sb_retnet_swa_hmoe'


def rms_norm(x, g):
    xf = x.astype(jnp.float32)
    y = xf * lax.rsqrt(jnp.mean(jnp.square(xf), axis=-1, keepdims=True) + EPS)
    return (y * g.astype(jnp.float32)).astype(x.dtype)


def rope_tables(seq):
    pos = jnp.arange(seq, dtype=jnp.float32)
    inv = ROPE_THETA ** (-jnp.arange(0, HEAD_DIM, 2, dtype=jnp.float32) / HEAD_DIM)
    ang = pos[:, None] * inv[None, :]
    return jnp.cos(ang), jnp.sin(ang)


def apply_rope(x, cos, sin):
    half = x.shape[-1] // 2
    xf = x.astype(jnp.float32)
    x1, x2 = xf[..., :half], xf[..., half:]
    c = cos[None, :, None, :]
    s = sin[None, :, None, :]
    return jnp.concatenate([x1 * c - x2 * s, x2 * c + x1 * s], axis=-1).astype(x.dtype)


def stick_breaking_attention(q, k, v):
    B, S, H, d = q.shape
    scale = d ** -0.5
    outs = []
    for start in range(0, S, Q_BLOCK):
        end = start + Q_BLOCK
        qb = q[:, start:end]
        kb = k[:, :end]
        vb = v[:, :end]
        z = jnp.einsum('bqhd,bkhd->bhqk', qb, kb).astype(jnp.float32) * scale
        qpos = start + jnp.arange(Q_BLOCK)
        kpos = jnp.arange(end)
        strict = kpos[None, :] < qpos[:, None]
        log_fail = jnp.where(strict, jax.nn.log_sigmoid(-z), 0.0)
        after = lax.cumsum(log_fail, axis=3, reverse=True) - log_fail
        w = jnp.where(strict, jnp.exp(jax.nn.log_sigmoid(z) + after), 0.0)
        outs.append(jnp.einsum('bhqk,bkhd->bqhd', w.astype(vb.dtype), vb))
    return jnp.concatenate(outs, axis=1)


def retention_chunkwise(q, k, v):
    B, S, H, d = q.shape
    C = RET_CHUNK
    n = S // C
    q = q.astype(jnp.float32)
    k = k.astype(jnp.float32) * (d ** -0.5)
    v = v.astype(jnp.float32)
    log_g = jnp.log(1.0 - 2.0 ** (-5.0 - jnp.arange(H, dtype=jnp.float32)))
    idx = jnp.arange(C, dtype=jnp.float32)
    diff = idx[:, None] - idx[None, :]
    decay_in = jnp.where(diff[None] >= 0, jnp.exp(log_g[:, None, None] * jnp.maximum(diff, 0.0)[None]), 0.0)
    xi = jnp.exp(log_g[:, None] * (idx[None, :] + 1.0))
    zeta = jnp.exp(log_g[:, None] * (C - 1.0 - idx[None, :]))
    g_chunk = jnp.exp(log_g * C)

    def to_chunks(t):
        return t.reshape(B, n, C, H, d).transpose(1, 0, 3, 2, 4)

    def step(R, inp):
        qi, ki, vi = inp
        inner = jnp.einsum('bhqd,bhkd->bhqk', qi, ki) * decay_in[None]
        o = jnp.einsum('bhqk,bhke->bhqe', inner, vi) + jnp.einsum('bhqd,bhde->bhqe', qi, R) * xi[None, :, :, None]
        R = R * g_chunk[None, :, None, None] + jnp.einsum('bhkd,bhke->bhde', ki * zeta[None, :, :, None], vi)
        return R, o

    R0 = jnp.zeros((B, H, d, d), jnp.float32)
    _, o = lax.scan(step, R0, (to_chunks(q), to_chunks(k), to_chunks(v)))
    return o.transpose(1, 0, 3, 2, 4).reshape(B, S, H, d)


def head_group_norm(y, gain):
    B, S, H, d = y.shape
    mu = jnp.mean(y, axis=-1, keepdims=True)
    var = jnp.mean(jnp.square(y - mu), axis=-1, keepdims=True)
    yn = (y - mu) * lax.rsqrt(var + EPS)
    return yn.reshape(B, S, H * d) * gain.astype(jnp.float32)


def sliding_window_gqa_sinks(q, k, v, sinks):
    B, S, Hq, d = q.shape
    Hkv = k.shape[2]
    G = Hq // Hkv
    W = WINDOW
    nb = S // W
    qb = q.reshape(B, nb, W, Hkv, G, d)

    def band(t):
        tp = jnp.pad(t, ((0, 0), (W, 0), (0, 0), (0, 0))).reshape(B, nb + 1, W, Hkv, d)
        return jnp.concatenate([tp[:, :-1], tp[:, 1:]], axis=2)

    kband, vband = band(k), band(v)
    s = jnp.einsum('bnqhgd,bnkhd->bnhgqk', qb, kband).astype(jnp.float32) * (d ** -0.5)
    qi = jnp.arange(W)[:, None]
    kj = jnp.arange(2 * W)[None, :]
    rel = qi + W - kj
    local = (rel >= 0) & (rel < W)
    blk = jnp.arange(nb)[:, None, None]
    valid = local[None] & ((blk > 0) | (kj[None] >= W))
    s = jnp.where(valid[None, :, None, None], s, -jnp.inf)
    sink = sinks.astype(jnp.float32).reshape(Hkv, G)[None, None, :, :, None, None]
    m = jnp.maximum(jnp.max(s, axis=-1, keepdims=True), sink)
    p = jnp.exp(s - m)
    p = p / (jnp.sum(p, axis=-1, keepdims=True) + jnp.exp(sink - m))
    o = jnp.einsum('bnhgqk,bnkhd->bnqhgd', p.astype(vband.dtype), vband)
    return o.reshape(B, S, Hq, d)


def mixer_ab(hn, w_in, gn_gain, w_out, cos, sin):
    B, S, _ = hn.shape
    proj = hn @ w_in
    cuts = list(np.cumsum([W_SB, W_SB, W_SB, W_RET, W_RET, W_RET])[:])
    qa, ka, va, qr, kr, vr, gr = jnp.split(proj, cuts, axis=-1)
    heads = lambda t, h: t.reshape(B, S, h, HEAD_DIM)
    a = stick_breaking_attention(heads(qa, N_HEADS_SB), heads(ka, N_HEADS_SB), heads(va, N_HEADS_SB))
    r = retention_chunkwise(apply_rope(heads(qr, N_HEADS_RET), cos, sin),
                            apply_rope(heads(kr, N_HEADS_RET), cos, sin),
                            heads(vr, N_HEADS_RET))
    r = head_group_norm(r, gn_gain) * jax.nn.silu(gr.astype(jnp.float32))
    cat = jnp.concatenate([a.reshape(B, S, W_SB), r.astype(a.dtype)], axis=-1)
    return cat @ w_out


def mixer_c(hn, w_in, b_in, sinks, w_out, b_out, cos, sin):
    B, S, _ = hn.shape
    proj = hn @ w_in + b_in
    q, k, v = jnp.split(proj, [W_Q_SWA, W_Q_SWA + W_KV_SWA], axis=-1)
    q = apply_rope(q.reshape(B, S, N_HEADS_SWA, HEAD_DIM), cos, sin)
    k = apply_rope(k.reshape(B, S, N_KV_SWA, HEAD_DIM), cos, sin)
    v = v.reshape(B, S, N_KV_SWA, HEAD_DIM)
    o = sliding_window_gqa_sinks(q, k, v, sinks)
    return o.reshape(B, S, W_Q_SWA) @ w_out + b_out


def hierarchical_moe(x, w_group, w_expert_router, w_gate, w_up, w_down):
    B, S, D = x.shape
    N = B * S
    M = MOE_BLOCK
    xf = x.reshape(N, D)
    group_probs = jax.nn.softmax((xf @ w_group).astype(jnp.float32), axis=-1)
    g_prob, g_idx = lax.top_k(group_probs, 1)
    e_logits = (xf @ w_expert_router).astype(jnp.float32).reshape(N, N_GROUPS, EXPERTS_PER_GROUP)
    e_logits = e_logits[jnp.arange(N), g_idx[:, 0]]
    e_prob, e_idx = lax.top_k(jax.nn.softmax(e_logits, axis=-1), TOP_K_IN_GROUP)
    e_prob = e_prob / jnp.sum(e_prob, axis=-1, keepdims=True)
    gate = (g_prob * e_prob).reshape(-1)
    eid = (g_idx * EXPERTS_PER_GROUP + e_idx).reshape(-1).astype(jnp.int32)
    tok = jnp.repeat(jnp.arange(N, dtype=jnp.int32), TOP_K_IN_GROUP)
    P = N * TOP_K_IN_GROUP
    order = jnp.argsort(eid)
    s_eid, s_tok, s_w = eid[order], tok[order], gate[order]
    counts = jnp.bincount(eid, length=N_EXPERTS).astype(jnp.int32)
    padded = ((counts + M - 1) // M) * M
    start = jnp.cumsum(counts) - counts
    pend = jnp.cumsum(padded)
    pstart = pend - padded
    dest = pstart[s_eid] + jnp.arange(P, dtype=jnp.int32) - start[s_eid]
    R = P + N_EXPERTS * M
    nblk = R // M
    row_tok = jnp.zeros((R,), jnp.int32).at[dest].set(s_tok)
    row_w = jnp.zeros((R,), s_w.dtype).at[dest].set(s_w)
    blk_exp = jnp.minimum(jnp.searchsorted(pend, jnp.arange(nblk, dtype=jnp.int32) * M, side='right'), N_EXPERTS - 1)
    xs = xf[row_tok].reshape(nblk, M, D)

    def expert_block(args):
        xb, e = args
        h = jax.nn.silu(xb @ w_gate[e]) * (xb @ w_up[e])
        return h @ w_down[e]

    ys = lax.map(expert_block, (xs, blk_exp)).reshape(R, D)
    y = jnp.zeros((N, D), ys.dtype).at[row_tok].add(ys * row_w[:, None].astype(ys.dtype))
    return y.reshape(B, S, D)


def setup_inputs(seed: int = 0) -> dict:
    key = jax.random.key(seed)
    ks = jax.random.split(key, 20)
    f32 = jnp.float32
    nrm = lambda k, shape, fan_in: jax.random.normal(k, shape, f32) * (fan_in ** -0.5)
    return {
        'x': jax.random.normal(ks[0], (BATCH, SEQ, D_MODEL), f32),
        'attn_norm_g': 1.0 + 0.02 * jax.random.normal(ks[1], (DEPTH, D_MODEL), f32),
        'ffn_norm_g': 1.0 + 0.02 * jax.random.normal(ks[2], (DEPTH, D_MODEL), f32),
        'w_in_ab': nrm(ks[3], (N_EVEN, D_MODEL, IN_AB), D_MODEL),
        'w_out_ab': nrm(ks[4], (N_EVEN, OUT_AB, D_MODEL), OUT_AB),
        'ret_gn_g': 1.0 + 0.02 * jax.random.normal(ks[5], (N_EVEN, W_RET), f32),
        'w_in_c': nrm(ks[6], (N_ODD, D_MODEL, IN_C), D_MODEL),
        'b_in_c': 0.02 * jax.random.normal(ks[7], (N_ODD, IN_C), f32),
        'sinks': 0.5 * jax.random.normal(ks[8], (N_ODD, N_HEADS_SWA), f32),
        'w_out_c': nrm(ks[9], (N_ODD, W_Q_SWA, D_MODEL), W_Q_SWA),
        'b_out_c': 0.02 * jax.random.normal(ks[10], (N_ODD, D_MODEL), f32),
        'w_group': nrm(ks[11], (DEPTH, D_MODEL, N_GROUPS), D_MODEL),
        'w_expert_router': nrm(ks[12], (DEPTH, D_MODEL, N_EXPERTS), D_MODEL),
        'w_gate': nrm(ks[13], (DEPTH, N_EXPERTS, D_MODEL, D_EXPERT), D_MODEL),
        'w_up': nrm(ks[14], (DEPTH, N_EXPERTS, D_MODEL, D_EXPERT), D_MODEL),
        'w_down': nrm(ks[15], (DEPTH, N_EXPERTS, D_EXPERT, D_MODEL), D_EXPERT),
        'final_norm_g': 1.0 + 0.02 * jax.random.normal(ks[16], (D_MODEL,), f32),
    }


def reference(x, attn_norm_g, ffn_norm_g, w_in_ab, w_out_ab, ret_gn_g, w_in_c, b_in_c, sinks,
              w_out_c, b_out_c, w_group, w_expert_router, w_gate, w_up, w_down, final_norm_g):
    S = x.shape[1]
    cos, sin = rope_tables(S)
    h = x
    for layer in range(DEPTH):
        i = layer // 2
        hn = rms_norm(h, attn_norm_g[layer])
        if layer % 2 == 0:
            mix = mixer_ab(hn, w_in_ab[i], ret_gn_g[i], w_out_ab[i], cos, sin)
        else:
            mix = mixer_c(hn, w_in_c[i], b_in_c[i], sinks[i], w_out_c[i], b_out_c[i], cos, sin)
        h = h + mix.astype(h.dtype)
        ff = hierarchical_moe(rms_norm(h, ffn_norm_g[layer]), w_group[layer], w_expert_router[layer],
                              w_gate[layer], w_up[layer], w_down[layer])
        h = h + ff.astype(h.dtype)
    return rms_norm(h, final_norm_g)
```

```cpp
#include <hip/hip_runtime.h>
#include <cstdio>
#include <cstdint>

#ifndef MK_SPLIT
#define MK_SPLIT 0
#endif
#ifndef PH_MASK
#define PH_MASK 0xffff
#endif

#define GAS __attribute__((address_space(1)))
#define LAS __attribute__((address_space(3)))
typedef unsigned short bf16;
typedef unsigned v4u __attribute__((ext_vector_type(4)));
typedef unsigned v2u __attribute__((ext_vector_type(2)));
typedef float f32x2 __attribute__((ext_vector_type(2)));
typedef float f32x4 __attribute__((ext_vector_type(4)));
typedef float f32x16 __attribute__((ext_vector_type(16)));
typedef short bf16x8 __attribute__((ext_vector_type(8)));
typedef short s16x4 __attribute__((ext_vector_type(4)));
typedef short v4i16_t __attribute__((ext_vector_type(4)));

constexpr int DM = 1024, SEQ = 2048, NB = 16, NTOK = NB * SEQ;
constexpr int IN_AB = 3584, IN_C = 1536, NEXP = 32, DEXP = 512;
constexpr float EPS = 1e-6f;
constexpr float LOG2E = 1.4426950408889634f;
constexpr float QSC = 0.125f * 1.4426950408889634f;
constexpr int NWAVES = 8, NTHR = 512;
constexpr int LISTCAP = 32768;
constexpr int YROWS = NTOK + 8;

constexpr size_t MiB = 1u << 20;
constexpr size_t WS_CTL = 0, CTL_ZERO_BYTES = 256 * 1024;
constexpr size_t WS_COS = 1 * MiB, WS_SIN = WS_COS + 256 * 1024, WS_GQ = WS_SIN + 256 * 1024, WS_GK = WS_GQ + 4096, WS_RSTD = WS_GQ + 256 * 1024;
constexpr size_t WS_WINAB = 2 * MiB, WS_WOUTAB = 9 * MiB, WS_WINC = 11 * MiB, WS_WOUTC = 14 * MiB;
constexpr size_t WS_WGU = 16 * MiB, WS_WD = 80 * MiB, WS_LIST = 112 * MiB;
constexpr size_t WS_HN = 128 * MiB, WS_CAT = 192 * MiB, WS_PROJ = 256 * MiB;
constexpr size_t WS_HID = 256 * MiB, WS_Y = 330 * MiB, WS_END = 480 * MiB;
static_assert(WS_Y + (size_t)2 * YROWS * DM * 2 <= WS_END, "ws map");
static_assert(WS_HID + (size_t)(65536 + 33 * 256) * DEXP * 2 <= WS_Y, "ws map");
constexpr int CW_TMO = 0;
constexpr int CW_CNT = 64;
constexpr int CW_BAR = 4096;

constexpr int RING_BYTES = 131072;
constexpr int MISC_OFF = RING_BYTES;
constexpr int LDS_BYTES = 147456;

__device__ __forceinline__ unsigned cvt_pk_bf16(float lo, float hi) { unsigned r; asm volatile("v_cvt_pk_bf16_f32 %0, %1, %2" : "=v"(r) : "v"(lo), "v"(hi)); return r; }
__device__ __forceinline__ float bf2f(unsigned short b) { return __uint_as_float((unsigned)b << 16); }
__device__ __forceinline__ float bflo(unsigned w) { return __uint_as_float(w << 16); }
__device__ __forceinline__ float bfhi(unsigned w) { return __uint_as_float(w & 0xffff0000u); }
__device__ __forceinline__ v4u pack8(f32x4 a, f32x4 b) { v4u w; w.x = cvt_pk_bf16(a[0], a[1]); w.y = cvt_pk_bf16(a[2], a[3]); w.z = cvt_pk_bf16(b[0], b[1]); w.w = cvt_pk_bf16(b[2], b[3]); return w; }
__device__ __forceinline__ float wave_sum(float v) {
#pragma unroll
    for (int o = 1; o < 64; o <<= 1) v += __shfl_xor(v, o);
    return v;
}
__device__ __forceinline__ float fexp2(float x) { return __builtin_amdgcn_exp2f(x); }
__device__ __forceinline__ float frcp(float x) { return __builtin_amdgcn_rcpf(x); }
#define LDS_WAIT() asm volatile("s_waitcnt lgkmcnt(0)" ::: "memory")
#define VM_WAIT() asm volatile("s_waitcnt vmcnt(0)" ::: "memory")

#define XB_TMO      128
#define XB_XCNT(j)  (256  + 64 * (j))
#define XB_XSUB(j)  (1280 + 64 * (j))
#define XB_XGEN(j)  (2304 + 64 * (j))
#define XB_TOP      3328
#define XB_TOPGEN   3392
#define XCD_BAR_WORDS 3456
#define XB_SPIN_CAP (1u << 18)
__device__ __forceinline__ unsigned xb_ld(unsigned* p)              { return __hip_atomic_load(p, __ATOMIC_RELAXED, __HIP_MEMORY_SCOPE_AGENT); }
__device__ __forceinline__ unsigned xb_add(unsigned* p, unsigned v) { return __hip_atomic_fetch_add(p, v, __ATOMIC_RELAXED, __HIP_MEMORY_SCOPE_AGENT); }
__device__ __forceinline__ unsigned xb_xcc_id() { return (unsigned)__builtin_amdgcn_s_getreg((3 << 11) | 20) & 0xFu; }
#define XB_SPIN(cond, bar) do { unsigned _sp = 0; while (cond) { __builtin_amdgcn_s_sleep(1); \
    if ((++_sp & 255u) == 0u) { if (xb_ld(&(bar)[XB_TMO])) break; if (_sp > XB_SPIN_CAP) { atomicAdd(&(bar)[XB_TMO], 1u); break; } } } } while (0)
struct XcdBarrier { unsigned* bar; unsigned x; volatile LAS unsigned* st; };
__device__ __forceinline__ XcdBarrier xcd_barrier_post(unsigned* bar, volatile LAS unsigned* st) {
    XcdBarrier b; b.bar = bar; b.x = xb_xcc_id(); b.st = st;
    if (threadIdx.x == 0) (void)xb_add(&bar[XB_XCNT(b.x)], 1u);
    return b;
}
__device__ __forceinline__ void xcd_barrier_complete(unsigned* bar, unsigned x, unsigned& nloc, unsigned& nx) {
    const unsigned G = gridDim.x * gridDim.y * gridDim.z;
    unsigned sum, cnt, mine, sp = 0u;
    for (;;) {
        sum = 0u; cnt = 0u; mine = 0u;
#pragma unroll
        for (unsigned j = 0; j < 16; ++j) { const unsigned c = xb_ld(&bar[XB_XCNT(j)]); sum += c; cnt += (c > 0u) ? 1u : 0u; mine = (j == x) ? c : mine; }
        if (sum == G) break;
        __builtin_amdgcn_s_sleep(1);
        if ((++sp & 255u) == 0u) { if (xb_ld(&bar[XB_TMO])) break; if (sp > XB_SPIN_CAP) { atomicAdd(&bar[XB_TMO], 1u); break; } }
    }
    nloc = mine > 0u ? mine : 1u; nx = cnt > 0u ? cnt : 1u;
}
__device__ __forceinline__ void xcd_barrier(const XcdBarrier& b) {
    asm volatile("s_waitcnt vmcnt(0)" ::: "memory");
    __syncthreads();
    if (threadIdx.x == 0) {
        unsigned* bar = b.bar;
        __builtin_amdgcn_s_waitcnt(0);
        unsigned nloc = b.st[0], nx = b.st[1];
        if (nloc == 0u) { xcd_barrier_complete(bar, b.x, nloc, nx); b.st[0] = nloc; b.st[1] = nx; }
        const unsigned old = xb_add(&bar[XB_XSUB(b.x)], 1u);
        const unsigned gen = old / nloc;
        if (old + 1u == (gen + 1u) * nloc) {
            __builtin_amdgcn_fence(__ATOMIC_RELEASE, "agent");
            asm volatile("s_waitcnt vmcnt(0)" ::: "memory");
            const unsigned og = xb_add(&bar[XB_TOP], 1u);
            const unsigned tg = og / nx;
            if (og + 1u == (tg + 1u) * nx) xb_add(&bar[XB_TOPGEN], 1u);
            else XB_SPIN(xb_ld(&bar[XB_TOPGEN]) == tg, bar);
            __builtin_amdgcn_fence(__ATOMIC_ACQUIRE, "agent");
            xb_add(&bar[XB_XGEN(b.x)], 1u);
            asm volatile("s_waitcnt vmcnt(0)" ::: "memory");
        } else {
            XB_SPIN(xb_ld(&bar[XB_XGEN(b.x)]) == gen, bar);
            __builtin_amdgcn_fence(__ATOMIC_ACQUIRE, "agent");
            asm volatile("s_waitcnt vmcnt(0)" ::: "memory");
        }
    }
    __syncthreads();
}

namespace pg8 {
constexpr int BM = 256, BK = 64, HALF = 128, HTB = HALF * BK * 2, STAGE_BYTES = 8 * HTB, NXCD = 8, WGM = 8;
__host__ __device__ __forceinline__ int lds_byte(int r, int c) { const int st = (r >> 4) * 2 + (c >> 5), rr = r & 15, cc = c & 31, ob = rr * 64 + cc * 2; return st * 1024 + (ob ^ (((ob >> 9) & 1) << 5)); }
__host__ __device__ __forceinline__ void stage_rc(int b, int& R, int& C) { const int st = b / 1024, sb = b % 1024, swz = sb ^ (((sb >> 9) & 1) << 5); R = (st >> 1) * 16 + swz / 64; C = (st & 1) * 32 + (swz % 64) / 2; }
__host__ __device__ __forceinline__ int perm32(int rho) { const int n = rho >> 4, i = rho & 15; return 8 * (i >> 2) + 4 * n + (i & 3); }

struct Unit { int pm, pn, e, rt0, cnt; };

struct DenseOrder {
    static constexpr bool GATHER = false;
    const char* A; const char* Bt; int K; int nM, nN, nwg, G, c;
    __device__ __forceinline__ void init(const void* A_, const void* Bt_, int M, int N, int K_, int G_, int c_) { A = (const char*)A_; Bt = (const char*)Bt_; K = K_; nM = M / BM; nN = N / BM; nwg = nM * nN; G = G_; c = c_; }
    __device__ __forceinline__ bool next(int i, Unit& u) const {
        const long L = (long)i * G + c; if (L >= nwg) return false;
        int wgid = (int)L; { const int q = nwg / NXCD, r = nwg % NXCD, xcd = wgid % NXCD, off = wgid / NXCD; wgid = (xcd < r ? xcd * (q + 1) : r * (q + 1) + (xcd - r) * q) + off; }
        const int nig = WGM * nN, gid = wgid / nig, fm = gid * WGM, gsz = (nM - fm) < WGM ? (nM - fm) : WGM;
        u.pm = fm + ((wgid % nig) % gsz); u.pn = (wgid % nig) / gsz; u.e = 0; u.rt0 = 0; u.cnt = 0; return true;
    }
    __device__ __forceinline__ const char* a_base(const Unit& u) const { return A + (size_t)u.pm * ((size_t)BM * K * 2); }
    __device__ __forceinline__ const char* b_base(const Unit& u) const { return Bt + (size_t)u.pn * ((size_t)BM * K * 2); }
    __device__ __forceinline__ void a_offs(const Unit&, const int (&Rp)[2], const int (&Cp)[2], unsigned (&v)[2][2]) const {
#pragma unroll
        for (int h = 0; h < 2; ++h)
#pragma unroll
            for (int i = 0; i < 2; ++i) v[h][i] = (unsigned)(((h * HALF + Rp[i]) * K + Cp[i]) * 2);
    }
};

template <class Epi, class Sched>
__device__ __forceinline__ void gemm_phase(LAS unsigned char* lds, const int K, const Sched& S, const Epi& E) {
    int tid_ = threadIdx.x; asm volatile("" : "+v"(tid_));
    const int tid = tid_, wid = __builtin_amdgcn_readfirstlane(tid >> 6), lane = tid & 63, wr = wid >> 2, wc = wid & 3, fr = lane & 15, fq = lane >> 4;
    const int nt = K / BK;
    int Rp[2], Cp[2]; unsigned voffB[2];
#pragma unroll
    for (int i = 0; i < 2; ++i) { int R, C; stage_rc(tid * 16 + i * 8192, R, C); Rp[i] = R; Cp[i] = C; const int Rb = Epi::PERM ? ((R & ~31) + perm32(R & 31)) : R; voffB[i] = (unsigned)(Rb * K + C) * 2u; }
    const size_t kstep = (size_t)(BK * 2);
    const size_t hstep = (size_t)HALF * K * 2;
    const unsigned ldsw = (unsigned)wid * 1024u;
    const int aoff = lds_byte(wr * 64 + fr, fq * 8), boff = lds_byte(wc * 32 + fr, fq * 8);
#define PG8_SA(b, h) (((b) * 2 + (h)) * HTB)
#define PG8_SB(b, h) ((4 + (b) * 2 + (h)) * HTB)
#define PG8_STAGE(bufoff, gbase, voff) do { _Pragma("unroll") for (int _i = 0; _i < 2; ++_i) { unsigned _o = (voff)[_i]; asm volatile("" : "+v"(_o)); \
        __builtin_amdgcn_global_load_lds((const unsigned*)((const char*)(gbase) + _o), (LAS unsigned*)(lds + (bufoff) + ldsw + _i * 8192), 16, 0, 0); } } while (0)
#define PG8_LDA(dst, b, h) do { _Pragma("unroll") for (int m = 0; m < 4; ++m) _Pragma("unroll") for (int k = 0; k < 2; ++k) dst[m][k] = *(const LAS bf16x8*)(lds + PG8_SA(b, h) + aoff + m * 2048 + k * 1024); } while (0)
#define PG8_LDB(dst, b, h) do { _Pragma("unroll") for (int n = 0; n < 2; ++n) _Pragma("unroll") for (int k = 0; k < 2; ++k) dst[n][k] = *(const LAS bf16x8*)(lds + PG8_SB(b, h) + boff + n * 2048 + k * 1024); } while (0)
#define PG8_MMA(ai, bj, At, Bt) do { __builtin_amdgcn_s_setprio(1); _Pragma("unroll") for (int m = 0; m < 4; ++m) _Pragma("unroll") for (int n = 0; n < 2; ++n) _Pragma("unroll") for (int k = 0; k < 2; ++k) \
        acc[ai][bj][m][n] = __builtin_amdgcn_mfma_f32_16x16x32_bf16(Bt[n][k], At[m][k], acc[ai][bj][m][n], 0, 0, 0); __builtin_amdgcn_s_setprio(0); } while (0)
#define PG8_WAIT_V(n) asm volatile("s_waitcnt vmcnt(" #n ")" ::: "memory")
#define PG8_WAIT_L(n) asm volatile("s_waitcnt lgkmcnt(" #n ")" ::: "memory")
#define PG8_BAR __builtin_amdgcn_s_barrier()
#define PG8_SCHED __builtin_amdgcn_sched_barrier(0)
    Unit cur, nxt; int ui = 0;
    if (!S.next(0, cur)) return;
    f32x4 acc[2][2][4][2];
#pragma unroll
    for (int a = 0; a < 2; ++a)
#pragma unroll
        for (int b = 0; b < 2; ++b)
#pragma unroll
            for (int m = 0; m < 4; ++m)
#pragma unroll
                for (int n = 0; n < 2; ++n) acc[a][b][m][n] = (f32x4){0.f, 0.f, 0.f, 0.f};
    bf16x8 At[4][2], B0[2][2], B1[2][2];
    unsigned cv[2][2], nv[2][2];
    S.a_offs(cur, Rp, Cp, cv);
    const char* cA = S.a_base(cur); const char* cB = S.b_base(cur);
    PG8_STAGE(PG8_SB(0, 0), cB, voffB); PG8_STAGE(PG8_SB(0, 1), cB + hstep, voffB); PG8_STAGE(PG8_SA(0, 0), cA, cv[0]); PG8_STAGE(PG8_SA(0, 1), cA, cv[1]);
    if (wr == 1) PG8_BAR;
    PG8_WAIT_V(2); PG8_BAR;
    PG8_STAGE(PG8_SB(1, 0), cB + kstep, voffB); PG8_STAGE(PG8_SA(1, 0), cA + kstep, cv[0]); PG8_STAGE(PG8_SB(1, 1), cB + hstep + kstep, voffB);
    PG8_WAIT_V(6); PG8_BAR;
    for (;;) {
        const bool has_next = S.next(ui + 1, nxt);
        const char* nA = cA; const char* nB = cB;
        if constexpr (Sched::GATHER) {
#pragma unroll
            for (int h = 0; h < 2; ++h)
#pragma unroll
                for (int i = 0; i < 2; ++i) nv[h][i] = cv[h][i];
        }
        if (has_next) { nA = S.a_base(nxt); nB = S.b_base(nxt); if constexpr (Sched::GATHER) S.a_offs(nxt, Rp, Cp, nv); }
        for (int t = 0; t < nt; t += 2) {
            const bool last = (t == nt - 2);
            const char* a1 = cA + (size_t)(t + 1) * kstep;
            const char* a2 = last ? nA : cA + (size_t)(t + 2) * kstep; const char* b2 = last ? nB : cB + (size_t)(t + 2) * kstep;
            const char* a3 = a2 + kstep; const char* b3 = b2 + kstep;
            unsigned o2[2][2];
#pragma unroll
            for (int h = 0; h < 2; ++h)
#pragma unroll
                for (int i = 0; i < 2; ++i) o2[h][i] = (Sched::GATHER && last) ? nv[h][i] : cv[h][i];
            PG8_LDB(B0, 0, 0); PG8_LDB(B1, 0, 1); PG8_SCHED; PG8_LDA(At, 0, 0); PG8_STAGE(PG8_SA(1, 1), a1, cv[1]);
            PG8_WAIT_V(8); PG8_WAIT_L(0); PG8_BAR; PG8_MMA(0, 0, At, B0); PG8_MMA(0, 1, At, B1); PG8_BAR; PG8_SCHED;
            PG8_LDA(At, 0, 1); PG8_STAGE(PG8_SB(0, 0), b2, voffB); PG8_STAGE(PG8_SB(0, 1), b2 + hstep, voffB); PG8_STAGE(PG8_SA(0, 0), a2, o2[0]);
            PG8_WAIT_V(8); PG8_WAIT_L(0); PG8_BAR; PG8_MMA(1, 0, At, B0); PG8_MMA(1, 1, At, B1); PG8_BAR; PG8_SCHED;
            PG8_LDB(B0, 1, 0); PG8_LDB(B1, 1, 1); PG8_SCHED; PG8_LDA(At, 1, 0); PG8_STAGE(PG8_SA(0, 1), a2, o2[1]);
            PG8_WAIT_V(8); PG8_WAIT_L(0); PG8_BAR; PG8_MMA(0, 0, At, B0); PG8_MMA(0, 1, At, B1); PG8_BAR; PG8_SCHED;
            PG8_LDA(At, 1, 1); PG8_STAGE(PG8_SB(1, 0), b3, voffB); PG8_STAGE(PG8_SB(1, 1), b3 + hstep, voffB); PG8_STAGE(PG8_SA(1, 0), a3, o2[0]);
            PG8_WAIT_V(8); PG8_WAIT_L(0); PG8_BAR; PG8_MMA(1, 0, At, B0); PG8_MMA(1, 1, At, B1); PG8_BAR; PG8_SCHED;
        }
        if (wr == 0) PG8_BAR;
        E(acc, cur, wr, wc, fr, fq);
        if (!has_next) break;
#pragma unroll
        for (int a = 0; a < 2; ++a)
#pragma unroll
            for (int b = 0; b < 2; ++b)
#pragma unroll
                for (int m = 0; m < 4; ++m)
#pragma unroll
                    for (int n = 0; n < 2; ++n) acc[a][b][m][n] = (f32x4){0.f, 0.f, 0.f, 0.f};
        cur = nxt; cA = nA; cB = nB; ++ui;
        if constexpr (Sched::GATHER) {
#pragma unroll
            for (int h = 0; h < 2; ++h)
#pragma unroll
                for (int i = 0; i < 2; ++i) cv[h][i] = nv[h][i];
        }
        if (wr == 1) PG8_BAR;
    }
    PG8_WAIT_V(0);
    PG8_BAR;
#undef PG8_SA
#undef PG8_SB
#undef PG8_STAGE
#undef PG8_LDA
#undef PG8_LDB
#undef PG8_MMA
#undef PG8_WAIT_V
#undef PG8_WAIT_L
#undef PG8_BAR
#undef PG8_SCHED
}
}
using pg8::Unit;

struct ListEnt { int tok; int dest; float gate; float rstd; };

struct Args { const float* in[17]; float* out; unsigned char* ws; int ph_lo, ph_hi; };

struct Frame {
    LAS unsigned char* lds;
    volatile LAS unsigned* MISC;
    unsigned* ctl;
    int tid, lane, wave, G, vcu;
    unsigned char* ws; float* out;
};
enum { I_X = 0, I_ATTN_G, I_FFN_G, I_W_IN_AB, I_W_OUT_AB, I_RET_GN, I_W_IN_C, I_B_IN_C, I_SINKS, I_W_OUT_C, I_B_OUT_C, I_W_GROUP, I_W_ER, I_W_GATE, I_W_UP, I_W_DOWN, I_FINAL_G };

__device__ __forceinline__ void transpose_tile(const float* __restrict__ W, int ldw, int k0, int nsrc0, bf16* __restrict__ WT, int ldt, int ndst0, LAS float* scr, int lane) {
#pragma unroll 8
    for (int i = 0; i < 32; ++i) { const int kk = 2 * i + (lane >> 5); scr[kk * 33 + (lane & 31)] = W[(size_t)(k0 + kk) * ldw + nsrc0 + (lane & 31)]; }
    LDS_WAIT(); asm volatile("" ::: "memory");
    const int c = lane & 7;
#pragma unroll
    for (int j = 0; j < 4; ++j) { const int n = (lane >> 3) + 8 * j; const LAS float* s = scr + (8 * c) * 33 + n;
        v4u o; o.x = cvt_pk_bf16(s[0 * 33], s[1 * 33]); o.y = cvt_pk_bf16(s[2 * 33], s[3 * 33]); o.z = cvt_pk_bf16(s[4 * 33], s[5 * 33]); o.w = cvt_pk_bf16(s[6 * 33], s[7 * 33]);
        *(v4u*)(WT + (size_t)(ndst0 + n) * ldt + k0 + 8 * c) = o; }
    LDS_WAIT(); asm volatile("" ::: "memory");
}
__device__ __forceinline__ int inproj_src_block(int pb) { const int pn = pb >> 3, t = pb & 7; return 8 * pn + 2 * (t & 3) + (t >> 2); }

__device__ __forceinline__ void convert_dense_weights(Frame& F, const Args& args) {
    LAS float* scr = (LAS float*)(F.lds + F.wave * 16384);
    const int gw = F.vcu * NWAVES + F.wave, NGW = F.G * NWAVES;
    constexpr int I_A = 16 * 112, I_B = 16 * 32, I_C = 16 * 48, I_D = 16 * 32;
    for (int it = gw; it < I_A + I_B + I_C + I_D; it += NGW) {
        int r = it;
        if (r < I_A) { const int kb = r / 112, nb = r % 112; transpose_tile(args.in[I_W_IN_AB], IN_AB, 64 * kb, 32 * inproj_src_block(nb), (bf16*)(F.ws + WS_WINAB), DM, 32 * nb, scr, F.lane); continue; } r -= I_A;
        if (r < I_B) { const int kb = r / 32, nb = r % 32; transpose_tile(args.in[I_W_OUT_AB], DM, 64 * kb, 32 * nb, (bf16*)(F.ws + WS_WOUTAB), DM, 32 * nb, scr, F.lane); continue; } r -= I_B;
        if (r < I_C) { const int kb = r / 48, nb = r % 48; transpose_tile(args.in[I_W_IN_C], IN_C, 64 * kb, 32 * inproj_src_block(nb), (bf16*)(F.ws + WS_WINC), DM, 32 * nb, scr, F.lane); continue; } r -= I_C;
        { const int kb = r / 32, nb = r % 32; transpose_tile(args.in[I_W_OUT_C], DM, 64 * kb, 32 * nb, (bf16*)(F.ws + WS_WOUTC), DM, 32 * nb, scr, F.lane); }
    }
}
__device__ __forceinline__ void convert_moe_weights(Frame& F, const Args& args, int layer) {
    LAS float* scr = (LAS float*)(F.lds + F.wave * 16384);
    const int gw = F.vcu * NWAVES + F.wave, NGW = F.G * NWAVES;
    const float* Wg = args.in[I_W_GATE] + (size_t)layer * NEXP * DM * DEXP;
    const float* Wu = args.in[I_W_UP] + (size_t)layer * NEXP * DM * DEXP;
    const float* Wd = args.in[I_W_DOWN] + (size_t)layer * NEXP * DEXP * DM;
    bf16* WGU = (bf16*)(F.ws + WS_WGU); bf16* WD = (bf16*)(F.ws + WS_WD);
    constexpr int PER_E = 16 * 32 + 8 * 32;
    for (int it = gw; it < NEXP * PER_E; it += NGW) {
        const int e = it / PER_E; int r = it % PER_E;
        if (r < 512) { const int kb = r / 32, nb = r % 32; const int pn = nb >> 3, s = (nb >> 2) & 1, jb = nb & 3;
            transpose_tile((s ? Wu : Wg) + (size_t)e * DM * DEXP, DEXP, 64 * kb, 32 * (4 * pn + jb), WGU + (size_t)e * 1024 * DM, DM, 32 * nb, scr, F.lane); }
        else { r -= 512; const int kb = r / 32, nb = r % 32;
            transpose_tile(Wd + (size_t)e * DEXP * DM, DM, 64 * kb, 32 * nb, WD + (size_t)e * DM * DEXP, DEXP, 32 * nb, scr, F.lane); }
    }
}
__device__ const double INVF[32] = {1.0, 0.7498942093324559, 0.5623413251903491, 0.4216965034285822, 0.31622776601683794, 0.23713737056616552, 0.1778279410038923, 0.1333521432163324, 0.09999999999999999, 0.07498942093324558, 0.056234132519034905, 0.042169650342858224, 0.03162277660168379, 0.023713737056616554, 0.01778279410038923, 0.013335214321633239, 0.01, 0.007498942093324559, 0.005623413251903491, 0.004216965034285822, 0.0031622776601683794, 0.002371373705661655, 0.0017782794100389228, 0.0013335214321633238, 0.001, 0.0007498942093324559, 0.000562341325190349, 0.00042169650342858224, 0.00031622776601683794, 0.00023713737056616554, 0.0001778279410038923, 0.0001333521432163324};
__device__ const float LG2G[8] = {-0.04580368961312479f, -0.02272007650008353f, -0.011315313227834146f, -0.005646563141142062f, -0.0028205190623786626f, -0.0014095702546713534f, -0.0007046129765893727f, -0.0003522634716290214f};
__device__ __forceinline__ void build_tables(Frame& F) {
    float* cosT = (float*)(F.ws + WS_COS); float* sinT = (float*)(F.ws + WS_SIN); float* gq = (float*)(F.ws + WS_GQ); float* gk = (float*)(F.ws + WS_GK);
    const int gt = F.vcu * NTHR + F.tid, NT = F.G * NTHR;
    for (int i = gt; i < SEQ * 32; i += NT) {
        const int t = i >> 5, f = i & 31;
        const double x = (double)t * INVF[f];
        const double n = __builtin_rint(x * 0.6366197723675814);
        double r = __builtin_fma(-n, 1.5707963267948966, x); r = __builtin_fma(-n, 6.123233995736766e-17, r);
        const float rf = (float)r, r2 = rf * rf;
        const float sp = rf + rf * r2 * (-1.6666667e-1f + r2 * (8.3333333e-3f + r2 * (-1.9841270e-4f + r2 * 2.7557319e-6f)));
        const float cp = 1.0f + r2 * (-0.5f + r2 * (4.1666668e-2f + r2 * (-1.3888889e-3f + r2 * 2.4801587e-5f)));
        const int q = ((int)n) & 3;
        float s = (q & 1) ? cp : sp, c = (q & 1) ? sp : cp;
        if (q == 1 || q == 2) c = -c;
        if (q >= 2) s = -s;
        cosT[i] = c; sinT[i] = s;
    }
    for (int i = gt; i < 8 * 128; i += NT) { const int h = i >> 7, p = i & 127; gq[i] = exp2f((float)p * LG2G[h]); gk[i] = exp2f(-(float)p * LG2G[h]) * 0.125f; }
}

template <int MODE>
__device__ __forceinline__ void norm_rows(Frame& F, const float* src, float* hbuf, const float* g) {
    const int gw = F.vcu * NWAVES + F.wave, NGW = F.G * NWAVES;
    float* rstd = (float*)(F.ws + WS_RSTD); bf16* hn = (bf16*)(F.ws + WS_HN);
    const bf16* y0 = (const bf16*)(F.ws + WS_Y); const bf16* y1 = y0 + (size_t)YROWS * DM;
    f32x4 gg[4];
#pragma unroll
    for (int j = 0; j < 4; ++j) gg[j] = *((const f32x4*)g + F.lane + 64 * j);
    for (int m = gw; m < NTOK; m += NGW) {
        const f32x4* xr = (const f32x4*)((MODE == 0 ? src : hbuf) + (size_t)m * DM) + F.lane;
        f32x4 v[4]; float s = 0.f;
#pragma unroll
        for (int j = 0; j < 4; ++j) v[j] = xr[64 * j];
        if (MODE != 0) {
#pragma unroll
            for (int j = 0; j < 4; ++j) { const v2u a = *((const v2u*)(y0 + (size_t)m * DM) + F.lane + 64 * j); const v2u b = *((const v2u*)(y1 + (size_t)m * DM) + F.lane + 64 * j);
                v[j][0] += bflo(a.x) + bflo(b.x); v[j][1] += bfhi(a.x) + bfhi(b.x); v[j][2] += bflo(a.y) + bflo(b.y); v[j][3] += bfhi(a.y) + bfhi(b.y); }
        }
#pragma unroll
        for (int j = 0; j < 4; ++j) s += (v[j][0] * v[j][0] + v[j][1] * v[j][1]) + (v[j][2] * v[j][2] + v[j][3] * v[j][3]);
        const float rs = 1.0f / sqrtf(wave_sum(s) * (1.0f / DM) + EPS);
        if (MODE == 2) {
            f32x4* o = (f32x4*)(hbuf + (size_t)m * DM) + F.lane;
#pragma unroll
            for (int j = 0; j < 4; ++j) o[64 * j] = v[j] * rs * gg[j];
        } else {
            if (MODE == 1) { f32x4* o = (f32x4*)(hbuf + (size_t)m * DM) + F.lane;
#pragma unroll
                for (int j = 0; j < 4; ++j) o[64 * j] = v[j]; }
            if (F.lane == 0) rstd[m] = rs;
            v2u* o8 = (v2u*)(hn + (size_t)m * DM) + F.lane;
#pragma unroll
            for (int j = 0; j < 4; ++j) { const f32x4 w = v[j] * gg[j]; v2u p; p.x = cvt_pk_bf16(w[0], w[1]); p.y = cvt_pk_bf16(w[2], w[3]); o8[64 * j] = p; }
        }
    }
}

constexpr size_t WS_RIMG = 512 * 1024;
__device__ __forceinline__ void build_router_image(Frame& F, const Args& args) {
    v4u* img = (v4u*)(F.ws + WS_RIMG);
    const int gt = F.vcu * NTHR + F.tid, NT = F.G * NTHR;
    for (int it = gt; it < 2 * 32 * 3 * 64; it += NT) {
        const int lane = it & 63, ct = (it >> 6) % 3, ks = (it / 192) & 31, layer = it / (192 * 32);
        const int r16 = lane & 15, q = lane >> 4;
        const float* wer = args.in[I_W_ER] + (size_t)layer * DM * 32; const float* wg = args.in[I_W_GROUP] + (size_t)layer * DM * 4;
        v4u hp, lp;
#pragma unroll
        for (int p = 0; p < 4; ++p) {
            const int k = 32 * ks + 8 * q + 2 * p;
            float v0, v1;
            if (ct < 2) { v0 = wer[(size_t)k * 32 + 16 * ct + r16]; v1 = wer[(size_t)(k + 1) * 32 + 16 * ct + r16]; }
            else { v0 = r16 < 4 ? wg[(size_t)k * 4 + r16] : 0.f; v1 = r16 < 4 ? wg[(size_t)(k + 1) * 4 + r16] : 0.f; }
            const unsigned h2 = cvt_pk_bf16(v0, v1); hp[p] = h2; lp[p] = cvt_pk_bf16(v0 - bflo(h2), v1 - bfhi(h2));
        }
        img[((size_t)((layer * 32 + ks) * 3 + ct) * 2 + 0) * 64 + lane] = hp;
        img[((size_t)((layer * 32 + ks) * 3 + ct) * 2 + 1) * 64 + lane] = lp;
    }
}
__device__ __forceinline__ void norm_router(Frame& F, const float* hbuf, const float* g, const v4u* rimg, unsigned* gcnt) {
    float* rstd = (float*)(F.ws + WS_RSTD); bf16* hn = (bf16*)(F.ws + WS_HN); ListEnt* list = (ListEnt*)(F.ws + WS_LIST);
    LAS float* gs = (LAS float*)(F.lds);
    LAS float* lgw = (LAS float*)(F.lds + 4096) + F.wave * 768;
    LAS int* lcnt = (LAS int*)(F.lds + 4096 + 24576);
    LAS int* lbase = lcnt + 32;
    const int l = F.lane, w = F.wave, r16 = l & 15, q = l >> 4;
    for (int i = F.tid; i < DM; i += NTHR) gs[i] = g[i];
    if (F.tid < 32) lcnt[F.tid] = 0;
    __syncthreads();
    for (int tile = F.vcu; tile < NTOK / 128; tile += F.G) {
        const int row = tile * 128 + w * 16 + r16;
        const float* hr = hbuf + (size_t)row * DM + 8 * q;
        bf16* hnr = hn + (size_t)row * DM + 8 * q;
        f32x4 acc[3] = {(f32x4){0.f, 0.f, 0.f, 0.f}, (f32x4){0.f, 0.f, 0.f, 0.f}, (f32x4){0.f, 0.f, 0.f, 0.f}};
        float ss = 0.f;
#pragma unroll 4
        for (int ks = 0; ks < 32; ++ks) {
            const f32x4 va = *(const f32x4*)(hr + 32 * ks), vb = *(const f32x4*)(hr + 32 * ks + 4);
            const f32x4 ga = *(const LAS f32x4*)(gs + 32 * ks + 8 * q), gb = *(const LAS f32x4*)(gs + 32 * ks + 8 * q + 4);
            ss += (va[0] * va[0] + va[1] * va[1]) + (va[2] * va[2] + va[3] * va[3]) + (vb[0] * vb[0] + vb[1] * vb[1]) + (vb[2] * vb[2] + vb[3] * vb[3]);
            const f32x4 xa = va * ga, xb = vb * gb;
            v4u hp, lp;
            hp.x = cvt_pk_bf16(xa[0], xa[1]); hp.y = cvt_pk_bf16(xa[2], xa[3]); hp.z = cvt_pk_bf16(xb[0], xb[1]); hp.w = cvt_pk_bf16(xb[2], xb[3]);
            lp.x = cvt_pk_bf16(xa[0] - bflo(hp.x), xa[1] - bfhi(hp.x)); lp.y = cvt_pk_bf16(xa[2] - bflo(hp.y), xa[3] - bfhi(hp.y));
            lp.z = cvt_pk_bf16(xb[0] - bflo(hp.z), xb[1] - bfhi(hp.z)); lp.w = cvt_pk_bf16(xb[2] - bflo(hp.w), xb[3] - bfhi(hp.w));
            *(v4u*)(hnr + 32 * ks) = hp;
            const bf16x8 ah = __builtin_bit_cast(bf16x8, hp), al = __builtin_bit_cast(bf16x8, lp);
            const v4u* bp = rimg + (size_t)(ks * 6) * 64 + l;
#pragma unroll
            for (int ct = 0; ct < 3; ++ct) {
                const bf16x8 bh = __builtin_bit_cast(bf16x8, bp[(2 * ct) * 64]), bl = __builtin_bit_cast(bf16x8, bp[(2 * ct + 1) * 64]);
                acc[ct] = __builtin_amdgcn_mfma_f32_16x16x32_bf16(ah, bh, acc[ct], 0, 0, 0);
                acc[ct] = __builtin_amdgcn_mfma_f32_16x16x32_bf16(al, bh, acc[ct], 0, 0, 0);
                acc[ct] = __builtin_amdgcn_mfma_f32_16x16x32_bf16(ah, bl, acc[ct], 0, 0, 0);
            }
        }
        ss += __shfl_xor(ss, 16); ss += __shfl_xor(ss, 32);
#pragma unroll
        for (int ct = 0; ct < 3; ++ct)
#pragma unroll
            for (int i = 0; i < 4; ++i) lgw[(4 * q + i) * 48 + ct * 16 + r16] = acc[ct][i];
        __syncthreads();
        int e1 = 0, e2 = 0, k1 = 0, k2 = 0; float g1 = 0.f, g2 = 0.f, rs = 0.f;
        if (l < 16) {
            rs = 1.0f / sqrtf(ss * (1.0f / DM) + EPS);
            float gl4[4];
#pragma unroll
            for (int c = 0; c < 4; ++c) gl4[c] = lgw[l * 48 + 32 + c] * rs;
            int gi = 0; float gm = gl4[0];
#pragma unroll
            for (int c = 1; c < 4; ++c) if (gl4[c] > gm) { gm = gl4[c]; gi = c; }
            float gden = 0.f;
#pragma unroll
            for (int c = 0; c < 4; ++c) gden += __expf(gl4[c] - gm);
            const float gprob = 1.0f / gden;
            float el[8];
#pragma unroll
            for (int c = 0; c < 8; ++c) el[c] = lgw[l * 48 + 8 * gi + c] * rs;
            int i1 = 0; float m1 = el[0];
#pragma unroll
            for (int c = 1; c < 8; ++c) if (el[c] > m1) { m1 = el[c]; i1 = c; }
            int i2 = 0; float m2 = -INFINITY;
#pragma unroll
            for (int c = 0; c < 8; ++c) if (c != i1 && el[c] > m2) { m2 = el[c]; i2 = c; }
            const float p2 = __expf(m2 - m1);
            const float inv = 1.0f / (1.0f + p2);
            g1 = gprob * inv; g2 = gprob * p2 * inv;
            e1 = 8 * gi + i1; e2 = 8 * gi + i2;
            rstd[row] = rs;
            k1 = atomicAdd((int*)&lcnt[e1], 1); k2 = atomicAdd((int*)&lcnt[e2], 1);
        }
        __syncthreads();
        if (F.tid < 32) { const int c = lcnt[F.tid]; int b = 0; if (c > 0) b = (int)__hip_atomic_fetch_add(gcnt + F.tid, (unsigned)c, __ATOMIC_RELAXED, __HIP_MEMORY_SCOPE_AGENT); lbase[F.tid] = b; lcnt[F.tid] = 0; }
        __syncthreads();
        if (l < 16) {
            const int s1 = lbase[e1] + k1, s2 = lbase[e2] + k2;
            ListEnt a; a.tok = row; a.dest = row; a.gate = g1; a.rstd = rs; list[(size_t)e1 * LISTCAP + s1] = a;
            ListEnt b; b.tok = row; b.dest = YROWS + row; b.gate = g2; b.rstd = rs; list[(size_t)e2 * LISTCAP + s2] = b;
        }
        __syncthreads();
    }
}

struct EpiInAB {
    static constexpr bool PERM = true;
    bf16* O; const float* rstd; const float* cosT; const float* sinT; const float* gq; const float* gk;
    __device__ __forceinline__ void operator()(const f32x4 (&acc)[2][2][4][2], const Unit& u, int wr, int wc, int fr, int fq) const {
        const int sec = u.pn >> 1, hh = 4 * (u.pn & 1) + wc;
        const int col0 = u.pn * 256 + 64 * wc + 8 * fq;
#pragma unroll
        for (int ai = 0; ai < 2; ++ai)
#pragma unroll
            for (int m = 0; m < 4; ++m) {
                const int row = u.pm * 256 + ai * 128 + wr * 64 + m * 16 + fr;
                const int t = row & (SEQ - 1);
                float mul = rstd[row];
                if (sec == 0) mul *= QSC;
                else if (sec == 3) mul *= gq[hh * 128 + (t & 127)];
                else if (sec == 4) mul *= gk[hh * 128 + (t & 127)];
                f32x4 x1[2], x2[2];
#pragma unroll
                for (int n = 0; n < 2; ++n) { x1[n] = acc[ai][0][m][n] * mul; x2[n] = acc[ai][1][m][n] * mul; }
                if (sec == 3 || sec == 4) {
#pragma unroll
                    for (int n = 0; n < 2; ++n) { const f32x4 c = *(const f32x4*)(cosT + t * 32 + 8 * fq + 4 * n), s = *(const f32x4*)(sinT + t * 32 + 8 * fq + 4 * n);
                        const f32x4 o1 = x1[n] * c - x2[n] * s, o2 = x2[n] * c + x1[n] * s; x1[n] = o1; x2[n] = o2; }
                }
                if (sec == 6) {
#pragma unroll
                    for (int n = 0; n < 2; ++n)
#pragma unroll
                        for (int i = 0; i < 4; ++i) { x1[n][i] = x1[n][i] * frcp(1.0f + fexp2(-LOG2E * x1[n][i])); x2[n][i] = x2[n][i] * frcp(1.0f + fexp2(-LOG2E * x2[n][i])); }
                }
                bf16* rp = O + (size_t)row * IN_AB + col0;
                *(v4u*)(rp) = pack8(x1[0], x1[1]); *(v4u*)(rp + 32) = pack8(x2[0], x2[1]);
                asm volatile("" ::: "memory");
            }
    }
};
struct EpiInC {
    static constexpr bool PERM = true;
    bf16* O; const float* rstd; const float* cosT; const float* sinT; const float* bias;
    __device__ __forceinline__ void operator()(const f32x4 (&acc)[2][2][4][2], const Unit& u, int wr, int wc, int fr, int fq) const {
        const int col0 = u.pn * 256 + 64 * wc + 8 * fq;
        f32x4 b1[2], b2[2];
#pragma unroll
        for (int n = 0; n < 2; ++n) { b1[n] = *(const f32x4*)(bias + col0 + 4 * n); b2[n] = *(const f32x4*)(bias + col0 + 32 + 4 * n); }
#pragma unroll
        for (int ai = 0; ai < 2; ++ai)
#pragma unroll
            for (int m = 0; m < 4; ++m) {
                const int row = u.pm * 256 + ai * 128 + wr * 64 + m * 16 + fr;
                const int t = row & (SEQ - 1);
                const float rs = rstd[row];
                f32x4 x1[2], x2[2];
#pragma unroll
                for (int n = 0; n < 2; ++n) { x1[n] = acc[ai][0][m][n] * rs + b1[n]; x2[n] = acc[ai][1][m][n] * rs + b2[n]; }
                if (u.pn < 5) {
                    const float sc = u.pn < 4 ? QSC : 1.0f;
#pragma unroll
                    for (int n = 0; n < 2; ++n) { const f32x4 c = *(const f32x4*)(cosT + t * 32 + 8 * fq + 4 * n), s = *(const f32x4*)(sinT + t * 32 + 8 * fq + 4 * n);
                        const f32x4 o1 = (x1[n] * c - x2[n] * s) * sc, o2 = (x2[n] * c + x1[n] * s) * sc; x1[n] = o1; x2[n] = o2; }
                }
                bf16* rp = O + (size_t)row * IN_C + col0;
                *(v4u*)(rp) = pack8(x1[0], x1[1]); *(v4u*)(rp + 32) = pack8(x2[0], x2[1]);
                asm volatile("" ::: "memory");
            }
    }
};
struct EpiOut {
    static constexpr bool PERM = false;
    const float* base; float* out; const float* bias;
    __device__ __forceinline__ void operator()(const f32x4 (&acc)[2][2][4][2], const Unit& u, int wr, int wc, int fr, int fq) const {
        const int col0 = u.pn * 256 + wc * 32 + 4 * fq;
        f32x4 bv[2][2];
#pragma unroll
        for (int bj = 0; bj < 2; ++bj)
#pragma unroll
            for (int n = 0; n < 2; ++n) bv[bj][n] = bias ? *(const f32x4*)(bias + col0 + bj * 128 + n * 16) : (f32x4){0.f, 0.f, 0.f, 0.f};
#pragma unroll
        for (int ai = 0; ai < 2; ++ai)
#pragma unroll
            for (int m = 0; m < 4; ++m) {
                const size_t off = (size_t)(u.pm * 256 + ai * 128 + wr * 64 + m * 16 + fr) * DM + col0;
#pragma unroll
                for (int bj = 0; bj < 2; ++bj)
#pragma unroll
                    for (int n = 0; n < 2; ++n) { const f32x4 b = *(const f32x4*)(base + off + bj * 128 + n * 16); *(f32x4*)(out + off + bj * 128 + n * 16) = b + acc[ai][bj][m][n] + bv[bj][n]; }
                if (m & 1) asm volatile("" ::: "memory");
            }
    }
};
struct EpiGateUp {
    static constexpr bool PERM = true;
    bf16* H; const ListEnt* list;
    __device__ __forceinline__ void operator()(const f32x4 (&acc)[2][2][4][2], const Unit& u, int wr, int wc, int fr, int fq) const {
        const int col0 = u.pn * 128 + 32 * wc + 8 * fq;
#pragma unroll
        for (int ai = 0; ai < 2; ++ai)
#pragma unroll
            for (int m = 0; m < 4; ++m) {
                const int rl = ai * 128 + wr * 64 + m * 16 + fr, r = u.rt0 + rl;
                const float rs = r < u.cnt ? list[(size_t)u.e * LISTCAP + r].rstd : 0.f;
                f32x4 o[2];
#pragma unroll
                for (int n = 0; n < 2; ++n)
#pragma unroll
                    for (int i = 0; i < 4; ++i) { const float gv = acc[ai][0][m][n][i] * rs, uv = acc[ai][1][m][n][i] * rs; o[n][i] = gv * uv * frcp(1.0f + fexp2(-LOG2E * gv)); }
                *(v4u*)(H + (size_t)(u.pm * 256 + rl) * DEXP + col0) = pack8(o[0], o[1]);
                asm volatile("" ::: "memory");
            }
    }
};
struct EpiDown {
    static constexpr bool PERM = true;
    bf16* Y; const ListEnt* list;
    __device__ __forceinline__ void operator()(const f32x4 (&acc)[2][2][4][2], const Unit& u, int wr, int wc, int fr, int fq) const {
        const int col0 = u.pn * 256 + 32 * wc + 8 * fq;
#pragma unroll
        for (int ai = 0; ai < 2; ++ai)
#pragma unroll
            for (int m = 0; m < 4; ++m) {
                const int r = u.rt0 + ai * 128 + wr * 64 + m * 16 + fr;
                int dest = NTOK; float gt = 0.f;
                if (r < u.cnt) { const ListEnt en = list[(size_t)u.e * LISTCAP + r]; dest = en.dest; gt = en.gate; }
                bf16* rp = Y + (size_t)dest * DM + col0;
#pragma unroll
                for (int bj = 0; bj < 2; ++bj) *(v4u*)(rp + bj * 128) = pack8(acc[ai][bj][m][0] * gt, acc[ai][bj][m][1] * gt);
                asm volatile("" ::: "memory");
            }
    }
};
template <bool GATHER_> struct MoeOrder {
    static constexpr bool GATHER = GATHER_; static constexpr bool gather = GATHER_;
    const LAS int* tp; const LAS int* cl; int total, G, c, K;
    const char* A; const char* Bt; const ListEnt* list; size_t bstride;
    __device__ __forceinline__ bool next(int i, Unit& u) const {
        const int L = i * G + c, T = L >> 2; if (T >= total) return false;
        int e = 0;
#pragma unroll 1
        for (int j = 1; j < 32; ++j) e += (tp[j] <= T) ? 1 : 0;
        e = __builtin_amdgcn_readfirstlane(e);
        u.e = e; u.pm = T; u.rt0 = (T - tp[e]) * 256; u.cnt = cl[e]; u.pn = L & 3; return true;
    }
    __device__ __forceinline__ const char* a_base(const Unit& u) const { return gather ? A : A + (size_t)u.pm * ((size_t)256 * K * 2); }
    __device__ __forceinline__ const char* b_base(const Unit& u) const { return Bt + (size_t)u.e * bstride + (size_t)u.pn * ((size_t)256 * K * 2); }
    __device__ __forceinline__ void a_offs(const Unit& u, const int (&Rp)[2], const int (&Cp)[2], unsigned (&v)[2][2]) const {
#pragma unroll
        for (int h = 0; h < 2; ++h)
#pragma unroll
            for (int i = 0; i < 2; ++i) {
                if (gather) { const int r = u.rt0 + h * 128 + Rp[i]; int tok = 0; if (r < u.cnt) tok = list[(size_t)u.e * LISTCAP + r].tok; v[h][i] = (unsigned)((tok * K + Cp[i]) * 2); }
                else v[h][i] = (unsigned)(((h * 128 + Rp[i]) * K + Cp[i]) * 2);
            }
    }
};
__device__ __forceinline__ void moe_tables(Frame& F, const unsigned* gcnt) {
    if (F.tid < 64) {
        int c = 0; if (F.tid < 32) c = (int)__hip_atomic_load(gcnt + F.tid, __ATOMIC_RELAXED, __HIP_MEMORY_SCOPE_AGENT);
        const int t = (c + 255) >> 8; int inc = t;
#pragma unroll
        for (int o = 1; o < 32; o <<= 1) { const int v = __shfl_up(inc, o); if ((F.tid & 63) >= o) inc += v; }
        if (F.tid < 32) { F.MISC[16 + F.tid] = (unsigned)(inc - t); F.MISC[64 + F.tid] = (unsigned)c; if (F.tid == 31) F.MISC[48] = (unsigned)inc; }
    }
    __syncthreads();
}

constexpr int KP = 144;
__device__ __forceinline__ int crow(int r, int hi) { return (r & 3) + 8 * (r >> 2) + 4 * hi; }
__device__ __forceinline__ s16x4 tr16(const LAS unsigned char* p) { return __builtin_bit_cast(s16x4, __builtin_amdgcn_ds_read_tr16_b64_v4i16((LAS v4i16_t*)p)); }
__device__ __forceinline__ bf16x8 trfrag(const LAS unsigned char* tile, int kv0, int c0, int lane) {
    const int hi = lane >> 5; const LAS unsigned char* p = tile + (kv0 + 4 * hi + ((lane & 15) >> 2)) * KP + (c0 + 16 * ((lane >> 4) & 1) + 4 * (lane & 3)) * 2;
    const s16x4 a = tr16(p), b = tr16(p + 8 * KP);
    return (bf16x8){a[0], a[1], a[2], a[3], b[0], b[1], b[2], b[3]};
}
__device__ __forceinline__ bf16x8 rowfrag(const LAS unsigned char* tile, int row, int c0) { return *(const LAS bf16x8*)(tile + row * KP + c0 * 2); }
__device__ __forceinline__ float swap_other(float v, int hi, float& prod) {
    auto rr = __builtin_amdgcn_permlane32_swap(__float_as_uint(v), __float_as_uint(v), false, false);
    const float lo = __uint_as_float(rr[0]), hv = __uint_as_float(rr[1]); prod = lo * hv; return hi ? lo : hv;
}
__device__ __forceinline__ bf16x8 packp(const f32x16& p, int b) {
    v4u w; w.x = cvt_pk_bf16(p[b], p[b + 1]); w.y = cvt_pk_bf16(p[b + 2], p[b + 3]); w.z = cvt_pk_bf16(p[b + 4], p[b + 5]); w.w = cvt_pk_bf16(p[b + 6], p[b + 7]); return __builtin_bit_cast(bf16x8, w);
}
__device__ __forceinline__ void store_ot(bf16* rowp, const f32x16& o0, const f32x16& o1, int hi) {
#pragma unroll
    for (int g = 0; g < 4; ++g) {
        v2u a; a.x = cvt_pk_bf16(o0[4 * g], o0[4 * g + 1]); a.y = cvt_pk_bf16(o0[4 * g + 2], o0[4 * g + 3]); *(v2u*)(rowp + 8 * g + 4 * hi) = a;
        v2u b; b.x = cvt_pk_bf16(o1[4 * g], o1[4 * g + 1]); b.y = cvt_pk_bf16(o1[4 * g + 2], o1[4 * g + 3]); *(v2u*)(rowp + 32 + 8 * g + 4 * hi) = b;
    }
}

constexpr float SB_DONE = 1e-13f;
__device__ __forceinline__ void sb_unit(Frame& F, int b, int h, int qb) {
    const bf16* proj = (const bf16*)(F.ws + WS_PROJ); bf16* cat = (bf16*)(F.ws + WS_CAT);
    LAS unsigned char* Kb = F.lds; LAS unsigned char* Vb = F.lds + 2 * 64 * KP; volatile LAS int* flags = (volatile LAS int*)(F.lds + 4 * 64 * KP);
    const int lane = F.lane, w = F.wave, r32 = lane & 31, hi = lane >> 5;
    const size_t rowbase = (size_t)b * SEQ;
    const int q0 = qb * 256 + 32 * w;
    const bf16* qrow = proj + (rowbase + q0 + r32) * IN_AB + 64 * h;
    bf16x8 qr[4];
#pragma unroll
    for (int d0 = 0; d0 < 4; ++d0) qr[d0] = *(const bf16x8*)(qrow + 16 * d0 + 8 * hi);
    const int lrow = F.tid >> 3, lch = F.tid & 7;
    const bf16* kg = proj + (rowbase + lrow) * IN_AB + 512 + 64 * h + 8 * lch;
    const bf16* vg = proj + (rowbase + lrow) * IN_AB + 1024 + 64 * h + 8 * lch;
    const int ldst = lrow * KP + lch * 16;
    const int Ttop = 4 * qb + 3;
    v4u kreg = *(const v4u*)(kg + (size_t)(64 * Ttop) * IN_AB), vreg = *(const v4u*)(vg + (size_t)(64 * Ttop) * IN_AB);
    if (lane == 0) flags[w] = 0;
    *(LAS v4u*)(Kb + ldst) = kreg; *(LAS v4u*)(Vb + ldst) = vreg;
    f32x16 o0 = {}, o1 = {};
    float carry = 1.0f;
    int cur = 0;
    for (int T = Ttop; T >= 0; --T) {
        __syncthreads();
        { int alld = 1;
#pragma unroll
          for (int j = 0; j < 8; ++j) alld &= flags[j];
          if (alld) break; }
        if (T > 0) { kreg = *(const v4u*)(kg + (size_t)(64 * (T - 1)) * IN_AB); vreg = *(const v4u*)(vg + (size_t)(64 * (T - 1)) * IN_AB); }
        const int Trel = T - 4 * qb;
        const bool active = Trel <= (w >> 1);
        if (active) {
            const LAS unsigned char* Kt = Kb + cur * 64 * KP; const LAS unsigned char* Vt = Vb + cur * 64 * KP;
            f32x16 p0 = {}, p1 = {};
#pragma unroll
            for (int d0 = 0; d0 < 4; ++d0) {
                const bf16x8 k0 = rowfrag(Kt, r32, 16 * d0 + 8 * hi), k1 = rowfrag(Kt, 32 + r32, 16 * d0 + 8 * hi);
                p0 = __builtin_amdgcn_mfma_f32_32x32x16_bf16(k0, qr[d0], p0, 0, 0, 0);
                p1 = __builtin_amdgcn_mfma_f32_32x32x16_bf16(k1, qr[d0], p1, 0, 0, 0);
            }
            f32x16 f0, f1;
            const bool diag = Trel == (w >> 1);
            const int qrel = 32 * w + r32, kbase = 64 * Trel;
#pragma unroll
            for (int r = 0; r < 16; ++r) {
                { const float e = fexp2(fminf(-p0[r], 80.f)); const float rc = frcp(1.0f + e); float bt = rc, ff = e * rc;
                  if (diag && (kbase + crow(r, hi) >= qrel)) { bt = 0.f; ff = 1.f; } p0[r] = bt; f0[r] = ff; }
                { const float e = fexp2(fminf(-p1[r], 80.f)); const float rc = frcp(1.0f + e); float bt = rc, ff = e * rc;
                  if (diag && (kbase + 32 + crow(r, hi) >= qrel)) { bt = 0.f; ff = 1.f; } p1[r] = bt; f1[r] = ff; }
            }
            float later[8], oth[8];
            { float Tg[8];
#pragma unroll
              for (int g = 0; g < 4; ++g) { const float Fa = (f0[4 * g] * f0[4 * g + 1]) * (f0[4 * g + 2] * f0[4 * g + 3]); oth[g] = swap_other(Fa, hi, Tg[g]);
                                           const float Fb = (f1[4 * g] * f1[4 * g + 1]) * (f1[4 * g + 2] * f1[4 * g + 3]); oth[4 + g] = swap_other(Fb, hi, Tg[4 + g]); }
              float run = carry;
#pragma unroll
              for (int idx = 7; idx >= 0; --idx) { later[idx] = run; run *= Tg[idx]; }
              carry = run; }
#pragma unroll
            for (int g = 0; g < 4; ++g) {
                { const float gf = later[g] * (hi ? 1.0f : oth[g]); const float s2 = f0[4 * g + 3], s1 = f0[4 * g + 2] * s2, s0 = f0[4 * g + 1] * s1;
                  p0[4 * g] *= s0 * gf; p0[4 * g + 1] *= s1 * gf; p0[4 * g + 2] *= s2 * gf; p0[4 * g + 3] *= gf; }
                { const float gf = later[4 + g] * (hi ? 1.0f : oth[4 + g]); const float s2 = f1[4 * g + 3], s1 = f1[4 * g + 2] * s2, s0 = f1[4 * g + 1] * s1;
                  p1[4 * g] *= s0 * gf; p1[4 * g + 1] *= s1 * gf; p1[4 * g + 2] *= s2 * gf; p1[4 * g + 3] *= gf; }
            }
            const bf16x8 pf0 = packp(p0, 0), pf1 = packp(p0, 8), pf2 = packp(p1, 0), pf3 = packp(p1, 8);
            o0 = __builtin_amdgcn_mfma_f32_32x32x16_bf16(trfrag(Vt, 0, 0, lane), pf0, o0, 0, 0, 0);
            o1 = __builtin_amdgcn_mfma_f32_32x32x16_bf16(trfrag(Vt, 0, 32, lane), pf0, o1, 0, 0, 0);
            o0 = __builtin_amdgcn_mfma_f32_32x32x16_bf16(trfrag(Vt, 16, 0, lane), pf1, o0, 0, 0, 0);
            o1 = __builtin_amdgcn_mfma_f32_32x32x16_bf16(trfrag(Vt, 16, 32, lane), pf1, o1, 0, 0, 0);
            o0 = __builtin_amdgcn_mfma_f32_32x32x16_bf16(trfrag(Vt, 32, 0, lane), pf2, o0, 0, 0, 0);
            o1 = __builtin_amdgcn_mfma_f32_32x32x16_bf16(trfrag(Vt, 32, 32, lane), pf2, o1, 0, 0, 0);
            o0 = __builtin_amdgcn_mfma_f32_32x32x16_bf16(trfrag(Vt, 48, 0, lane), pf3, o0, 0, 0, 0);
            o1 = __builtin_amdgcn_mfma_f32_32x32x16_bf16(trfrag(Vt, 48, 32, lane), pf3, o1, 0, 0, 0);
            const int dn = __all(carry < SB_DONE) ? 1 : 0;
            if (lane == 0) flags[w] = dn;
        }
        if (T > 0) { *(LAS v4u*)(Kb + (cur ^ 1) * 64 * KP + ldst) = kreg; *(LAS v4u*)(Vb + (cur ^ 1) * 64 * KP + ldst) = vreg; }
        cur ^= 1;
    }
    store_ot(cat + (rowbase + q0 + r32) * DM + 64 * h, o0, o1, hi);
    __syncthreads();
}

__device__ __forceinline__ void ret_chain(Frame& F, const float* gn, int b, int h) {
    const bf16* proj = (const bf16*)(F.ws + WS_PROJ); bf16* cat = (bf16*)(F.ws + WS_CAT);
    LAS unsigned char* Qs = F.lds; LAS unsigned char* Ks = F.lds + 128 * KP; LAS unsigned char* Vs = F.lds + 256 * KP; LAS unsigned char* RT = F.lds + 384 * KP;
    const int lane = F.lane, w = F.wave, r32 = lane & 31, hi = lane >> 5;
    const size_t rowbase = (size_t)b * SEQ;
    const float gam = 1.0f - exp2f(-5.0f - (float)h), g127 = exp2f(127.f * LG2G[h]), g128 = exp2f(128.f * LG2G[h]);
    const int lr0 = F.tid >> 3, lch = F.tid & 7;
    const bf16* gq_ = proj + (rowbase + lr0) * IN_AB + 1536 + 64 * h + 8 * lch;
    v4u rq[2], rk[2], rv[2];
#pragma unroll
    for (int i = 0; i < 2; ++i) { const bf16* p = gq_ + (size_t)(64 * i) * IN_AB; rq[i] = *(const v4u*)p; rk[i] = *(const v4u*)(p + 512); rv[i] = *(const v4u*)(p + 1024); }
    f32x16 Racc = {};
    const int dt = (w >> 1) & 1, et = w & 1;
    if (w >= 4) {
#pragma unroll
        for (int g = 0; g < 4; ++g) *(LAS v2u*)(RT + (32 * et + r32) * KP + (32 * dt + 8 * g + 4 * hi) * 2) = (v2u){0u, 0u};
    }
    float gnv[2][4][4], dummy = 0.f; (void)dummy;
    if (w < 4) {
#pragma unroll
        for (int d0 = 0; d0 < 2; ++d0)
#pragma unroll
            for (int g = 0; g < 4; ++g)
#pragma unroll
                for (int i = 0; i < 4; ++i) gnv[d0][g][i] = gn[64 * h + 32 * d0 + 8 * g + 4 * hi + i];
    }
    for (int c = 0; c < 16; ++c) {
#pragma unroll
        for (int i = 0; i < 2; ++i) { const int o = (lr0 + 64 * i) * KP + lch * 16; *(LAS v4u*)(Qs + o) = rq[i]; *(LAS v4u*)(Ks + o) = rk[i]; *(LAS v4u*)(Vs + o) = rv[i]; }
        __syncthreads();
        if (c < 15) {
#pragma unroll
            for (int i = 0; i < 2; ++i) { const bf16* p = gq_ + (size_t)(128 * (c + 1) + 64 * i) * IN_AB; rq[i] = *(const v4u*)p; rk[i] = *(const v4u*)(p + 512); rv[i] = *(const v4u*)(p + 1024); }
        }
        const LAS unsigned char* Rc = RT + (c & 1) * 64 * KP;
        if (w < 4) {
            bf16x8 qr[4];
#pragma unroll
            for (int d0 = 0; d0 < 4; ++d0) qr[d0] = rowfrag(Qs, 32 * w + r32, 16 * d0 + 8 * hi);
            f32x16 o0 = {}, o1 = {};
#pragma unroll
            for (int ks = 0; ks < 4; ++ks) {
                o0 = __builtin_amdgcn_mfma_f32_32x32x16_bf16(rowfrag(Rc, r32, 16 * ks + 8 * hi), qr[ks], o0, 0, 0, 0);
                o1 = __builtin_amdgcn_mfma_f32_32x32x16_bf16(rowfrag(Rc, 32 + r32, 16 * ks + 8 * hi), qr[ks], o1, 0, 0, 0);
            }
#pragma unroll
            for (int r = 0; r < 16; ++r) { o0[r] *= gam; o1[r] *= gam; }
#pragma unroll
            for (int blk = 0; blk < 4; ++blk) {
                if (blk <= w) {
                    f32x16 p = {};
#pragma unroll
                    for (int d0 = 0; d0 < 4; ++d0) p = __builtin_amdgcn_mfma_f32_32x32x16_bf16(rowfrag(Ks, 32 * blk + r32, 16 * d0 + 8 * hi), qr[d0], p, 0, 0, 0);
                    if (blk == w) {
#pragma unroll
                        for (int r = 0; r < 16; ++r) if (crow(r, hi) > r32) p[r] = 0.f;
                    }
                    const bf16x8 pa = packp(p, 0), pb = packp(p, 8);
                    o0 = __builtin_amdgcn_mfma_f32_32x32x16_bf16(trfrag(Vs, 32 * blk, 0, lane), pa, o0, 0, 0, 0);
                    o1 = __builtin_amdgcn_mfma_f32_32x32x16_bf16(trfrag(Vs, 32 * blk, 32, lane), pa, o1, 0, 0, 0);
                    o0 = __builtin_amdgcn_mfma_f32_32x32x16_bf16(trfrag(Vs, 32 * blk + 16, 0, lane), pb, o0, 0, 0, 0);
                    o1 = __builtin_amdgcn_mfma_f32_32x32x16_bf16(trfrag(Vs, 32 * blk + 16, 32, lane), pb, o1, 0, 0, 0);
                }
            }
            float s = 0.f;
#pragma unroll
            for (int r = 0; r < 16; ++r) s += o0[r] + o1[r];
            { auto rr = __builtin_amdgcn_permlane32_swap(__float_as_uint(s), __float_as_uint(s), false, false); s = __uint_as_float(rr[0]) + __uint_as_float(rr[1]); }
            const float mu = s * (1.0f / 64.0f);
            float vs = 0.f;
#pragma unroll
            for (int r = 0; r < 16; ++r) { const float a = o0[r] - mu, bb = o1[r] - mu; vs += a * a + bb * bb; }
            { auto rr = __builtin_amdgcn_permlane32_swap(__float_as_uint(vs), __float_as_uint(vs), false, false); vs = __uint_as_float(rr[0]) + __uint_as_float(rr[1]); }
            const float rsd = 1.0f / sqrtf(vs * (1.0f / 64.0f) + EPS);
            const size_t grow = rowbase + 128 * c + 32 * w + r32;
            const bf16* gp = proj + grow * IN_AB + 3072 + 64 * h;
#pragma unroll
            for (int d0 = 0; d0 < 2; ++d0)
#pragma unroll
                for (int g = 0; g < 4; ++g) {
                    const v2u gv = *(const v2u*)(gp + 32 * d0 + 8 * g + 4 * hi);
                    const float sg[4] = {bflo(gv.x), bfhi(gv.x), bflo(gv.y), bfhi(gv.y)};
#pragma unroll
                    for (int i = 0; i < 4; ++i) { if (d0) o1[4 * g + i] = (o1[4 * g + i] - mu) * rsd * gnv[d0][g][i] * sg[i]; else o0[4 * g + i] = (o0[4 * g + i] - mu) * rsd * gnv[d0][g][i] * sg[i]; }
                }
            store_ot(cat + grow * DM + 512 + 64 * h, o0, o1, hi);
        } else {
            f32x16 tmp = {};
#pragma unroll
            for (int ks = 0; ks < 8; ++ks) tmp = __builtin_amdgcn_mfma_f32_32x32x16_bf16(trfrag(Ks, 16 * ks, 32 * dt, lane), trfrag(Vs, 16 * ks, 32 * et, lane), tmp, 0, 0, 0);
#pragma unroll
            for (int r = 0; r < 16; ++r) Racc[r] = g128 * Racc[r] + g127 * tmp[r];
            LAS unsigned char* Rn = RT + ((c + 1) & 1) * 64 * KP;
#pragma unroll
            for (int g = 0; g < 4; ++g) { v2u a; a.x = cvt_pk_bf16(Racc[4 * g], Racc[4 * g + 1]); a.y = cvt_pk_bf16(Racc[4 * g + 2], Racc[4 * g + 3]);
                *(LAS v2u*)(Rn + (32 * et + r32) * KP + (32 * dt + 8 * g + 4 * hi) * 2) = a; }
        }
        __syncthreads();
    }
}

__device__ __forceinline__ void swa_unit(Frame& F, const float* sinks, int b, int g, int n) {
    const bf16* proj = (const bf16*)(F.ws + WS_PROJ); bf16* cat = (bf16*)(F.ws + WS_CAT);
    LAS unsigned char* Kb = F.lds; LAS unsigned char* Vb = F.lds + 256 * KP;
    const int lane = F.lane, w = F.wave, r32 = lane & 31, hi = lane >> 5;
    const size_t rowbase = (size_t)b * SEQ;
    {
        const int lch = F.tid & 7;
#pragma unroll
        for (int i = 0; i < 4; ++i) {
            const int br = (F.tid >> 3) + 64 * i; int pos = 128 * (n - 1) + br; pos = pos < 0 ? 0 : pos;
            const bf16* p = proj + (rowbase + pos) * IN_C + 1024 + 64 * g + 8 * lch;
            *(LAS v4u*)(Kb + br * KP + lch * 16) = *(const v4u*)p; *(LAS v4u*)(Vb + br * KP + lch * 16) = *(const v4u*)(p + 256);
        }
    }
    __syncthreads();
    const int hq = 4 * g + (w >> 1);
    const float sink2 = sinks[hq] * LOG2E;
#pragma unroll 1
    for (int rg = 0; rg < 2; ++rg) {
        const int r0 = 64 * (w & 1) + 32 * rg;
        const size_t qrow = rowbase + 128 * n + r0 + r32;
        const bf16* qp = proj + qrow * IN_C + 64 * hq;
        bf16x8 qr[4];
#pragma unroll
        for (int d0 = 0; d0 < 4; ++d0) qr[d0] = *(const bf16x8*)(qp + 16 * d0 + 8 * hi);
        f32x16 s[5];
        const int blk0 = r0 >> 5;
#pragma unroll
        for (int i = 0; i < 5; ++i) {
            s[i] = (f32x16){};
#pragma unroll
            for (int d0 = 0; d0 < 4; ++d0) s[i] = __builtin_amdgcn_mfma_f32_32x32x16_bf16(rowfrag(Kb, 32 * (blk0 + i) + r32, 16 * d0 + 8 * hi), qr[d0], s[i], 0, 0, 0);
        }
        const int qi = r0 + r32;
        float m = sink2;
#pragma unroll
        for (int i = 0; i < 5; ++i)
#pragma unroll
            for (int r = 0; r < 16; ++r) { const int kb = 32 * (blk0 + i) + crow(r, hi); const int rel = qi + 128 - kb; const bool ok = (rel >= 0) && (rel < 128) && (n > 0 || kb >= 128);
                s[i][r] = ok ? s[i][r] : -INFINITY; m = fmaxf(m, s[i][r]); }
        { auto rr = __builtin_amdgcn_permlane32_swap(__float_as_uint(m), __float_as_uint(m), false, false); m = fmaxf(__uint_as_float(rr[0]), __uint_as_float(rr[1])); }
        float l = 0.f;
#pragma unroll
        for (int i = 0; i < 5; ++i)
#pragma unroll
            for (int r = 0; r < 16; ++r) { const float p = fexp2(s[i][r] - m); s[i][r] = p; l += p; }
        { auto rr = __builtin_amdgcn_permlane32_swap(__float_as_uint(l), __float_as_uint(l), false, false); l = __uint_as_float(rr[0]) + __uint_as_float(rr[1]); }
        l += fexp2(sink2 - m);
        const float il = 1.0f / l;
        f32x16 o0 = {}, o1 = {};
#pragma unroll
        for (int i = 0; i < 5; ++i) {
            const bf16x8 pa = packp(s[i], 0), pb = packp(s[i], 8);
            const int kv0 = 32 * (blk0 + i);
            o0 = __builtin_amdgcn_mfma_f32_32x32x16_bf16(trfrag(Vb, kv0, 0, lane), pa, o0, 0, 0, 0);
            o1 = __builtin_amdgcn_mfma_f32_32x32x16_bf16(trfrag(Vb, kv0, 32, lane), pa, o1, 0, 0, 0);
            o0 = __builtin_amdgcn_mfma_f32_32x32x16_bf16(trfrag(Vb, kv0 + 16, 0, lane), pb, o0, 0, 0, 0);
            o1 = __builtin_amdgcn_mfma_f32_32x32x16_bf16(trfrag(Vb, kv0 + 16, 32, lane), pb, o1, 0, 0, 0);
        }
#pragma unroll
        for (int r = 0; r < 16; ++r) { o0[r] *= il; o1[r] *= il; }
        store_ot(cat + qrow * DM + 64 * hq, o0, o1, hi);
    }
    __syncthreads();
}


#define IN(k) (lo <= (k) && (k) < hi)
#define EN(b) ((PH_MASK >> (b)) & 1)
#define SEAM(k) do { if (IN(k) && IN((k) + 1)) { XcdBarrier bb_ = bar; asm volatile("" : "+s"(bb_.bar)); xcd_barrier(bb_); } } while (0)
template <int layer>
__device__ __forceinline__ void layer_phases(Frame& F, const Args& args, const XcdBarrier& bar, const int lo, const int hi) {

        const int pb = 1 + 7 * layer;
        { unsigned char* w_ = args.ws; asm volatile("" : "+s"(w_)); F.ws = w_; F.ctl = (unsigned*)(w_ + WS_CTL); }
        float* const hbuf = F.out;
        const float* cosT = (const float*)(F.ws + WS_COS); const float* sinT = (const float*)(F.ws + WS_SIN);
        const float* gqT = (const float*)(F.ws + WS_GQ); const float* gkT = (const float*)(F.ws + WS_GK);
        const float* rstd = (const float*)(F.ws + WS_RSTD);
        const ListEnt* list = (const ListEnt*)(F.ws + WS_LIST);
        if (EN(1) && IN(pb)) {
            if (layer == 0) {
                pg8::DenseOrder S; S.init(F.ws + WS_HN, F.ws + WS_WINAB, NTOK, IN_AB, DM, F.G, (int)blockIdx.x);
                EpiInAB E{(bf16*)(F.ws + WS_PROJ), rstd, cosT, sinT, gqT, gkT};
                pg8::gemm_phase<EpiInAB, pg8::DenseOrder>(F.lds, DM, S, E);
            } else {
                pg8::DenseOrder S; S.init(F.ws + WS_HN, F.ws + WS_WINC, NTOK, IN_C, DM, F.G, (int)blockIdx.x);
                EpiInC E{(bf16*)(F.ws + WS_PROJ), rstd, cosT, sinT, args.in[I_B_IN_C]};
                pg8::gemm_phase<EpiInC, pg8::DenseOrder>(F.lds, DM, S, E);
            }
        }
        SEAM(pb);
        if (EN(2) && IN(pb + 1)) {
            if (layer == 0) {
                const int bh = F.vcu >> 1, half = F.vcu & 1;
                if (F.G == 256) {
                    if (half == 0) ret_chain(F, args.in[I_RET_GN], bh >> 3, bh & 7);
#pragma unroll 1
                    for (int i = 0; i < 4; ++i) { const int qb = half == 0 ? ((i == 0) ? 0 : (i == 1) ? 7 : (i == 2) ? 2 : 5) : ((i == 0) ? 1 : (i == 1) ? 6 : (i == 2) ? 3 : 4); sb_unit(F, bh >> 3, bh & 7, qb); }
                } else {
#pragma unroll 1
                    for (int u = F.vcu; u < 128; u += F.G) ret_chain(F, args.in[I_RET_GN], u >> 3, u & 7);
#pragma unroll 1
                    for (int u = F.vcu; u < 1024; u += F.G) sb_unit(F, u >> 6, (u >> 3) & 7, u & 7);
                }
            } else {
#pragma unroll 1
                for (int u = F.vcu; u < NB * 4 * 16; u += F.G) swa_unit(F, args.in[I_SINKS], u >> 6, (u >> 4) & 3, u & 15);
            }
        }
        SEAM(pb + 1);
        if (EN(3) && IN(pb + 2)) {
            pg8::DenseOrder S; S.init(F.ws + WS_CAT, F.ws + (layer == 0 ? WS_WOUTAB : WS_WOUTC), NTOK, DM, DM, F.G, (int)blockIdx.x);
            EpiOut E{layer == 0 ? args.in[I_X] : hbuf, hbuf, layer == 0 ? nullptr : args.in[I_B_OUT_C]};
            pg8::gemm_phase<EpiOut, pg8::DenseOrder>(F.lds, DM, S, E);
        }
        SEAM(pb + 2);
        if (EN(4) && IN(pb + 3)) {
            norm_router(F, hbuf, args.in[I_FFN_G] + layer * DM, (const v4u*)(F.ws + WS_RIMG) + (size_t)layer * 32 * 6 * 64, F.ctl + CW_CNT + 32 * layer);
        }
        SEAM(pb + 3);
        if (EN(5) && IN(pb + 4)) {
            moe_tables(F, F.ctl + CW_CNT + 32 * layer);
            MoeOrder<true> S{(const LAS int*)(F.MISC + 16), (const LAS int*)(F.MISC + 64), (int)F.MISC[48], F.G, F.vcu, DM, (const char*)(F.ws + WS_HN), (const char*)(F.ws + WS_WGU), list, (size_t)1024 * DM * 2};
            EpiGateUp E{(bf16*)(F.ws + WS_HID), list};
            pg8::gemm_phase<EpiGateUp, MoeOrder<true>>(F.lds, DM, S, E);
        }
        SEAM(pb + 4);
        if (EN(6) && IN(pb + 5)) {
            moe_tables(F, F.ctl + CW_CNT + 32 * layer);
            MoeOrder<false> S{(const LAS int*)(F.MISC + 16), (const LAS int*)(F.MISC + 64), (int)F.MISC[48], F.G, F.vcu, DEXP, (const char*)(F.ws + WS_HID), (const char*)(F.ws + WS_WD), list, (size_t)DM * DEXP * 2};
            EpiDown E{(bf16*)(F.ws + WS_Y), list};
            pg8::gemm_phase<EpiDown, MoeOrder<false>>(F.lds, DEXP, S, E);
        }
        SEAM(pb + 5);
        if (EN(7) && IN(pb + 6)) {
            if (layer == 0) { convert_moe_weights(F, args, 1); norm_rows<1>(F, nullptr, hbuf, args.in[I_ATTN_G] + DM); }
            else norm_rows<2>(F, nullptr, hbuf, args.in[I_FINAL_G]);
        }
        if (layer == 0) SEAM(pb + 6);
    }

__global__ void __launch_bounds__(NTHR, 2) mega_fwd(Args args) {
    extern __shared__ __attribute__((aligned(16))) unsigned char lds_raw[];
    Frame F;
    F.lds = (LAS unsigned char*)lds_raw;
    F.MISC = (volatile LAS unsigned*)(F.lds + MISC_OFF);
    F.tid = threadIdx.x; F.lane = F.tid & 63; F.wave = __builtin_amdgcn_readfirstlane(F.tid >> 6);
    F.G = gridDim.x; { const int bx = blockIdx.x; F.vcu = (F.G % 8 == 0) ? (bx % 8) * (F.G / 8) + bx / 8 : bx; }
    F.ws = args.ws; F.out = args.out; F.ctl = (unsigned*)(args.ws + WS_CTL);
    if (F.tid < 128) F.MISC[F.tid] = 0u;
    __syncthreads();
    XcdBarrier bar; bar.bar = F.ctl + CW_BAR; bar.x = 0; bar.st = nullptr;
    if (!MK_SPLIT) bar = xcd_barrier_post(F.ctl + CW_BAR, F.MISC + 8);
    const int lo = args.ph_lo, hi = args.ph_hi;

    if (EN(0) && IN(0)) {
        build_tables(F);
        build_router_image(F, args);
        convert_dense_weights(F, args);
        convert_moe_weights(F, args, 0);
        norm_rows<0>(F, args.in[I_X], nullptr, args.in[I_ATTN_G]);
    }
    SEAM(0);
    layer_phases<0>(F, args, bar, lo, hi);
    layer_phases<1>(F, args, bar, lo, hi);
#undef IN
#undef SEAM
}

extern "C" void kernel_launch(void* const* d_in, const int* in_sizes, int n_in, void* d_out, int out_size, void* d_ws, size_t ws_size, hipStream_t stream) {
    static int grid = 0;
    if (grid == 0) {
        if (n_in != 17 || out_size != NTOK * DM || ws_size < WS_END) { fprintf(stderr, "kernel_launch: unexpected shapes (n_in %d out %d ws %zu)\n", n_in, out_size, ws_size); grid = -1; return; }
        int dev = 0, cus = 0, per_cu = 0;
        if (hipGetDevice(&dev) != hipSuccess || hipDeviceGetAttribute(&cus, hipDeviceAttributeMultiprocessorCount, dev) != hipSuccess) { grid = -1; return; }
        if (hipFuncSetAttribute((const void*)mega_fwd, hipFuncAttributeMaxDynamicSharedMemorySize, LDS_BYTES) != hipSuccess) { fprintf(stderr, "kernel_launch: hipFuncSetAttribute failed\n"); grid = -1; return; }
        if (hipOccupancyMaxActiveBlocksPerMultiprocessor(&per_cu, (const void*)mega_fwd, NTHR, LDS_BYTES) != hipSuccess || per_cu < 1) { fprintf(stderr, "kernel_launch: occupancy query says %d\n", per_cu); }
        (void)hipGetLastError();
        grid = cus;
    }
    if (grid < 0) return;
    (void)hipMemsetAsync((char*)d_ws + WS_CTL, 0, CTL_ZERO_BYTES, stream);
    Args a{};
    for (int i = 0; i < 17; ++i) a.in[i] = (const float*)d_in[i];
    a.out = (float*)d_out; a.ws = (unsigned char*)d_ws;
#if MK_SPLIT
    for (int p = 0; p < 15; ++p) { a.ph_lo = p; a.ph_hi = p + 1; hipLaunchKernelGGL(mega_fwd, dim3(grid), dim3(NTHR), LDS_BYTES, stream, a); }
#else
    a.ph_lo = 0; a.ph_hi = 15;
    hipLaunchKernelGGL(mega_fwd, dim3(grid), dim3(NTHR), LDS_BYTES, stream, a);
#endif
}
```

```cpp
#include <hip/hip_runtime.h>
#include <cstdio>
#include <cstdint>

#ifndef MK_SPLIT
#define MK_SPLIT 0
#endif
#ifndef SB_REP
#define SB_REP 1
#endif
#ifndef RET_REP
#define RET_REP 1
#endif
#ifndef PROBE_REP
#define PROBE_REP 1
#endif
#ifndef PH_MASK
#define PH_MASK 0xffff
#endif

#define GAS __attribute__((address_space(1)))
#define LAS __attribute__((address_space(3)))
typedef unsigned short bf16;
typedef unsigned v4u __attribute__((ext_vector_type(4)));
typedef unsigned v2u __attribute__((ext_vector_type(2)));
typedef float f32x2 __attribute__((ext_vector_type(2)));
typedef float f32x4 __attribute__((ext_vector_type(4)));
typedef float f32x16 __attribute__((ext_vector_type(16)));
typedef short bf16x8 __attribute__((ext_vector_type(8)));
typedef short s16x4 __attribute__((ext_vector_type(4)));
typedef short v4i16_t __attribute__((ext_vector_type(4)));

constexpr int DM = 1024, SEQ = 2048, NB = 16, NTOK = NB * SEQ;
constexpr int IN_AB = 3584, IN_C = 1536, NEXP = 32, DEXP = 512;
constexpr float EPS = 1e-6f;
constexpr float LOG2E = 1.4426950408889634f;
constexpr float QSC = 0.125f * 1.4426950408889634f;
constexpr int NWAVES = 8, NTHR = 512;
constexpr int LISTCAP = 32768;
constexpr int YROWS = NTOK + 8;

constexpr size_t MiB = 1u << 20;
constexpr size_t WS_CTL = 0, CTL_ZERO_BYTES = 256 * 1024;
constexpr size_t WS_COS = 1 * MiB, WS_SIN = WS_COS + 256 * 1024, WS_GQ = WS_SIN + 256 * 1024, WS_GK = WS_GQ + 4096, WS_RSTD = WS_GQ + 256 * 1024;
constexpr size_t WS_WINAB = 2 * MiB, WS_WOUTAB = 9 * MiB, WS_WINC = 11 * MiB, WS_WOUTC = 14 * MiB;
constexpr size_t WS_WGU = 16 * MiB, WS_WD = 80 * MiB, WS_LIST = 112 * MiB;
constexpr size_t WS_HN = 128 * MiB, WS_CAT = 192 * MiB, WS_PROJ = 256 * MiB;
constexpr size_t WS_HID = 256 * MiB, WS_Y = 330 * MiB, WS_END = 480 * MiB;
static_assert(WS_Y + (size_t)2 * YROWS * DM * 2 <= WS_END, "ws map");
static_assert(WS_HID + (size_t)(65536 + 33 * 256) * DEXP * 2 <= WS_Y, "ws map");
constexpr int CW_TMO = 0;
constexpr int CW_CNT = 64;
constexpr int CW_BAR = 4096;

constexpr int RING_BYTES = 131072;
constexpr int MISC_OFF = RING_BYTES;
constexpr int LDS_BYTES = 147456;

__device__ __forceinline__ unsigned cvt_pk_bf16(float lo, float hi) { unsigned r; asm volatile("v_cvt_pk_bf16_f32 %0, %1, %2" : "=v"(r) : "v"(lo), "v"(hi)); return r; }
__device__ __forceinline__ float bf2f(unsigned short b) { return __uint_as_float((unsigned)b << 16); }
__device__ __forceinline__ float bflo(unsigned w) { return __uint_as_float(w << 16); }
__device__ __forceinline__ float bfhi(unsigned w) { return __uint_as_float(w & 0xffff0000u); }
__device__ __forceinline__ v4u pack8(f32x4 a, f32x4 b) { v4u w; w.x = cvt_pk_bf16(a[0], a[1]); w.y = cvt_pk_bf16(a[2], a[3]); w.z = cvt_pk_bf16(b[0], b[1]); w.w = cvt_pk_bf16(b[2], b[3]); return w; }
__device__ __forceinline__ float wave_sum(float v) {
#pragma unroll
    for (int o = 1; o < 64; o <<= 1) v += __shfl_xor(v, o);
    return v;
}
__device__ __forceinline__ float fexp2(float x) { return __builtin_amdgcn_exp2f(x); }
__device__ __forceinline__ float frcp(float x) { return __builtin_amdgcn_rcpf(x); }
#define LDS_WAIT() asm volatile("s_waitcnt lgkmcnt(0)" ::: "memory")
#define VM_WAIT() asm volatile("s_waitcnt vmcnt(0)" ::: "memory")

#define XB_TMO      128
#define XB_XCNT(j)  (256  + 64 * (j))
#define XB_XSUB(j)  (1280 + 64 * (j))
#define XB_XGEN(j)  (2304 + 64 * (j))
#define XB_TOP      3328
#define XB_TOPGEN   3392
#define XCD_BAR_WORDS 3456
#define XB_SPIN_CAP (1u << 18)
__device__ __forceinline__ unsigned xb_ld(unsigned* p)              { return __hip_atomic_load(p, __ATOMIC_RELAXED, __HIP_MEMORY_SCOPE_AGENT); }
__device__ __forceinline__ unsigned xb_add(unsigned* p, unsigned v) { return __hip_atomic_fetch_add(p, v, __ATOMIC_RELAXED, __HIP_MEMORY_SCOPE_AGENT); }
__device__ __forceinline__ unsigned xb_xcc_id() { return (unsigned)__builtin_amdgcn_s_getreg((3 << 11) | 20) & 0xFu; }
#define XB_SPIN(cond, bar) do { unsigned _sp = 0; while (cond) { __builtin_amdgcn_s_sleep(1); \
    if ((++_sp & 255u) == 0u) { if (xb_ld(&(bar)[XB_TMO])) break; if (_sp > XB_SPIN_CAP) { atomicAdd(&(bar)[XB_TMO], 1u); break; } } } } while (0)
struct XcdBarrier { unsigned* bar; unsigned x; volatile LAS unsigned* st; };
__device__ __forceinline__ XcdBarrier xcd_barrier_post(unsigned* bar, volatile LAS unsigned* st) {
    XcdBarrier b; b.bar = bar; b.x = xb_xcc_id(); b.st = st;
    if (threadIdx.x == 0) (void)xb_add(&bar[XB_XCNT(b.x)], 1u);
    return b;
}
__device__ __forceinline__ void xcd_barrier_complete(unsigned* bar, unsigned x, unsigned& nloc, unsigned& nx) {
    const unsigned G = gridDim.x * gridDim.y * gridDim.z;
    unsigned sum, cnt, mine, sp = 0u;
    for (;;) {
        sum = 0u; cnt = 0u; mine = 0u;
#pragma unroll
        for (unsigned j = 0; j < 16; ++j) { const unsigned c = xb_ld(&bar[XB_XCNT(j)]); sum += c; cnt += (c > 0u) ? 1u : 0u; mine = (j == x) ? c : mine; }
        if (sum == G) break;
        __builtin_amdgcn_s_sleep(1);
        if ((++sp & 255u) == 0u) { if (xb_ld(&bar[XB_TMO])) break; if (sp > XB_SPIN_CAP) { atomicAdd(&bar[XB_TMO], 1u); break; } }
    }
    nloc = mine > 0u ? mine : 1u; nx = cnt > 0u ? cnt : 1u;
}
__device__ __forceinline__ void xcd_barrier(const XcdBarrier& b) {
    asm volatile("s_waitcnt vmcnt(0)" ::: "memory");
    __syncthreads();
    if (threadIdx.x == 0) {
        unsigned* bar = b.bar;
        __builtin_amdgcn_s_waitcnt(0);
        unsigned nloc = b.st[0], nx = b.st[1];
        if (nloc == 0u) { xcd_barrier_complete(bar, b.x, nloc, nx); b.st[0] = nloc; b.st[1] = nx; }
        const unsigned old = xb_add(&bar[XB_XSUB(b.x)], 1u);
        const unsigned gen = old / nloc;
        if (old + 1u == (gen + 1u) * nloc) {
            __builtin_amdgcn_fence(__ATOMIC_RELEASE, "agent");
            asm volatile("s_waitcnt vmcnt(0)" ::: "memory");
            const unsigned og = xb_add(&bar[XB_TOP], 1u);
            const unsigned tg = og / nx;
            if (og + 1u == (tg + 1u) * nx) xb_add(&bar[XB_TOPGEN], 1u);
            else XB_SPIN(xb_ld(&bar[XB_TOPGEN]) == tg, bar);
            __builtin_amdgcn_fence(__ATOMIC_ACQUIRE, "agent");
            xb_add(&bar[XB_XGEN(b.x)], 1u);
            asm volatile("s_waitcnt vmcnt(0)" ::: "memory");
        } else {
            XB_SPIN(xb_ld(&bar[XB_XGEN(b.x)]) == gen, bar);
            __builtin_amdgcn_fence(__ATOMIC_ACQUIRE, "agent");
            asm volatile("s_waitcnt vmcnt(0)" ::: "memory");
        }
    }
    __syncthreads();
}

namespace pg8 {
constexpr int BM = 256, BK = 64, HALF = 128, HTB = HALF * BK * 2, STAGE_BYTES = 8 * HTB, NXCD = 8, WGM = 8;
__host__ __device__ __forceinline__ int lds_byte(int r, int c) { const int st = (r >> 4) * 2 + (c >> 5), rr = r & 15, cc = c & 31, ob = rr * 64 + cc * 2; return st * 1024 + (ob ^ (((ob >> 9) & 1) << 5)); }
__host__ __device__ __forceinline__ void stage_rc(int b, int& R, int& C) { const int st = b / 1024, sb = b % 1024, swz = sb ^ (((sb >> 9) & 1) << 5); R = (st >> 1) * 16 + swz / 64; C = (st & 1) * 32 + (swz % 64) / 2; }
__host__ __device__ __forceinline__ int perm32(int rho) { const int n = rho >> 4, i = rho & 15; return 8 * (i >> 2) + 4 * n + (i & 3); }

struct Unit { int pm, pn, e, rt0, cnt, vr; };

struct DenseOrder {
    static constexpr bool GATHER = false, PARTIAL = false;
    const char* A; const char* Bt; int K; int nM, nN, nwg, G, c;
    __device__ __forceinline__ void init(const void* A_, const void* Bt_, int M, int N, int K_, int G_, int c_) { A = (const char*)A_; Bt = (const char*)Bt_; K = K_; nM = M / BM; nN = N / BM; nwg = nM * nN; G = G_; c = c_; }
    __device__ __forceinline__ bool next(int i, Unit& u) const {
        const long L = (long)i * G + c; if (L >= nwg) return false;
        int wgid = (int)L; { const int q = nwg / NXCD, r = nwg % NXCD, xcd = wgid % NXCD, off = wgid / NXCD; wgid = (xcd < r ? xcd * (q + 1) : r * (q + 1) + (xcd - r) * q) + off; }
        const int nig = WGM * nN, gid = wgid / nig, fm = gid * WGM, gsz = (nM - fm) < WGM ? (nM - fm) : WGM;
        u.pm = fm + ((wgid % nig) % gsz); u.pn = (wgid % nig) / gsz; u.e = 0; u.rt0 = 0; u.cnt = 0; u.vr = 256; return true;
    }
    __device__ __forceinline__ const char* a_base(const Unit& u) const { return A + (size_t)u.pm * ((size_t)BM * K * 2); }
    __device__ __forceinline__ const char* b_base(const Unit& u) const { return Bt + (size_t)u.pn * ((size_t)BM * K * 2); }
    __device__ __forceinline__ void a_offs(const Unit&, const int (&Rp)[2], const int (&Cp)[2], unsigned (&v)[2][2]) const {
#pragma unroll
        for (int h = 0; h < 2; ++h)
#pragma unroll
            for (int i = 0; i < 2; ++i) v[h][i] = (unsigned)(((h * HALF + Rp[i]) * K + Cp[i]) * 2);
    }
};

template <class Epi, class Sched>
__device__ __forceinline__ void gemm_phase(LAS unsigned char* lds, const int K, const Sched& S, const Epi& E) {
    int tid_ = threadIdx.x; asm volatile("" : "+v"(tid_));
    const int tid = tid_, wid = __builtin_amdgcn_readfirstlane(tid >> 6), lane = tid & 63, wr = wid >> 2, wc = wid & 3, fr = lane & 15, fq = lane >> 4;
    const int nt = K / BK;
    int Rp[2], Cp[2]; unsigned voffB[2];
#pragma unroll
    for (int i = 0; i < 2; ++i) { int R, C; stage_rc(tid * 16 + i * 8192, R, C); Rp[i] = R; Cp[i] = C; const int Rb = Epi::PERM ? ((R & ~31) + perm32(R & 31)) : R; voffB[i] = (unsigned)(Rb * K + C) * 2u; }
    const size_t kstep = (size_t)(BK * 2);
    const size_t hstep = (size_t)HALF * K * 2;
    const unsigned ldsw = (unsigned)wid * 1024u;
    const int aoff = lds_byte(wr * 64 + fr, fq * 8), boff = lds_byte(wc * 32 + fr, fq * 8);
#define PG8_SA(b, h) (((b) * 2 + (h)) * HTB)
#define PG8_SB(b, h) ((4 + (b) * 2 + (h)) * HTB)
#define PG8_STAGE(bufoff, gbase, voff) do { _Pragma("unroll") for (int _i = 0; _i < 2; ++_i) { unsigned _o = (voff)[_i]; asm volatile("" : "+v"(_o)); \
        __builtin_amdgcn_global_load_lds((const unsigned*)((const char*)(gbase) + _o), (LAS unsigned*)(lds + (bufoff) + ldsw + _i * 8192), 16, 0, 0); } } while (0)
#define PG8_LDA(dst, b, h) do { _Pragma("unroll") for (int m = 0; m < 4; ++m) _Pragma("unroll") for (int k = 0; k < 2; ++k) dst[m][k] = *(const LAS bf16x8*)(lds + PG8_SA(b, h) + aoff + m * 2048 + k * 1024); } while (0)
#define PG8_LDB(dst, b, h) do { _Pragma("unroll") for (int n = 0; n < 2; ++n) _Pragma("unroll") for (int k = 0; k < 2; ++k) dst[n][k] = *(const LAS bf16x8*)(lds + PG8_SB(b, h) + boff + n * 2048 + k * 1024); } while (0)
#define PG8_MMA(ai, bj, At, Bt) do { __builtin_amdgcn_s_setprio(1); _Pragma("unroll") for (int m = 0; m < 4; ++m) _Pragma("unroll") for (int n = 0; n < 2; ++n) _Pragma("unroll") for (int k = 0; k < 2; ++k) \
        acc[ai][bj][m][n] = __builtin_amdgcn_mfma_f32_16x16x32_bf16(Bt[n][k], At[m][k], acc[ai][bj][m][n], 0, 0, 0); __builtin_amdgcn_s_setprio(0); } while (0)
#define PG8_MMAG(ai, bj, At, Bt) do { _Pragma("unroll") for (int m = 0; m < 4; ++m) { if (m < mc[ai]) { _Pragma("unroll") for (int n = 0; n < 2; ++n) _Pragma("unroll") for (int k = 0; k < 2; ++k) \
        acc[ai][bj][m][n] = __builtin_amdgcn_mfma_f32_16x16x32_bf16(Bt[n][k], At[m][k], acc[ai][bj][m][n], 0, 0, 0); } } } while (0)
#define PG8_WAIT_V(n) asm volatile("s_waitcnt vmcnt(" #n ")" ::: "memory")
#define PG8_WAIT_L(n) asm volatile("s_waitcnt lgkmcnt(" #n ")" ::: "memory")
#define PG8_BAR __builtin_amdgcn_s_barrier()
#define PG8_SCHED __builtin_amdgcn_sched_barrier(0)
#define PG8_TLOOP(MMA_) \
        for (int t = 0; t < nt; t += 2) { \
            const bool last = (t == nt - 2); \
            const char* a1 = cA + (size_t)(t + 1) * kstep; \
            const char* a2 = last ? nA : cA + (size_t)(t + 2) * kstep; const char* b2 = last ? nB : cB + (size_t)(t + 2) * kstep; \
            const char* a3 = a2 + kstep; const char* b3 = b2 + kstep; \
            unsigned o2[2][2]; \
_Pragma("unroll") \
            for (int h = 0; h < 2; ++h) \
_Pragma("unroll") \
                for (int i = 0; i < 2; ++i) o2[h][i] = (Sched::GATHER && last) ? nv[h][i] : cv[h][i]; \
            PG8_LDB(B0, 0, 0); PG8_LDB(B1, 0, 1); PG8_SCHED; PG8_LDA(At, 0, 0); PG8_STAGE(PG8_SA(1, 1), a1, cv[1]); \
            PG8_WAIT_V(8); PG8_WAIT_L(0); PG8_BAR; MMA_(0, 0, At, B0); MMA_(0, 1, At, B1); PG8_BAR; PG8_SCHED; \
            PG8_LDA(At, 0, 1); PG8_STAGE(PG8_SB(0, 0), b2, voffB); PG8_STAGE(PG8_SB(0, 1), b2 + hstep, voffB); PG8_STAGE(PG8_SA(0, 0), a2, o2[0]); \
            PG8_WAIT_V(8); PG8_WAIT_L(0); PG8_BAR; MMA_(1, 0, At, B0); MMA_(1, 1, At, B1); PG8_BAR; PG8_SCHED; \
            PG8_LDB(B0, 1, 0); PG8_LDB(B1, 1, 1); PG8_SCHED; PG8_LDA(At, 1, 0); PG8_STAGE(PG8_SA(0, 1), a2, o2[1]); \
            PG8_WAIT_V(8); PG8_WAIT_L(0); PG8_BAR; MMA_(0, 0, At, B0); MMA_(0, 1, At, B1); PG8_BAR; PG8_SCHED; \
            PG8_LDA(At, 1, 1); PG8_STAGE(PG8_SB(1, 0), b3, voffB); PG8_STAGE(PG8_SB(1, 1), b3 + hstep, voffB); PG8_STAGE(PG8_SA(1, 0), a3, o2[0]); \
            PG8_WAIT_V(8); PG8_WAIT_L(0); PG8_BAR; MMA_(1, 0, At, B0); MMA_(1, 1, At, B1); PG8_BAR; PG8_SCHED; \
        }
    Unit cur, nxt; int ui = 0;
    if (!S.next(0, cur)) return;
    f32x4 acc[2][2][4][2];
#pragma unroll
    for (int a = 0; a < 2; ++a)
#pragma unroll
        for (int b = 0; b < 2; ++b)
#pragma unroll
            for (int m = 0; m < 4; ++m)
#pragma unroll
                for (int n = 0; n < 2; ++n) acc[a][b][m][n] = (f32x4){0.f, 0.f, 0.f, 0.f};
    bf16x8 At[4][2], B0[2][2], B1[2][2];
    unsigned cv[2][2], nv[2][2];
    S.a_offs(cur, Rp, Cp, cv);
    const char* cA = S.a_base(cur); const char* cB = S.b_base(cur);
    int mc[2] = {4, 4};
#define PG8_SETMC(u) do { if constexpr (Sched::PARTIAL) { _Pragma("unroll") for (int a_ = 0; a_ < 2; ++a_) { int v_ = ((u).vr - 128 * a_ - 64 * wr + 15) >> 4; v_ = v_ < 0 ? 0 : (v_ > 4 ? 4 : v_); mc[a_] = __builtin_amdgcn_readfirstlane(v_); } } } while (0)
    PG8_SETMC(cur);
    PG8_STAGE(PG8_SB(0, 0), cB, voffB); PG8_STAGE(PG8_SB(0, 1), cB + hstep, voffB); PG8_STAGE(PG8_SA(0, 0), cA, cv[0]); PG8_STAGE(PG8_SA(0, 1), cA, cv[1]);
    if (wr == 1) PG8_BAR;
    PG8_WAIT_V(2); PG8_BAR;
    PG8_STAGE(PG8_SB(1, 0), cB + kstep, voffB); PG8_STAGE(PG8_SA(1, 0), cA + kstep, cv[0]); PG8_STAGE(PG8_SB(1, 1), cB + hstep + kstep, voffB);
    PG8_WAIT_V(6); PG8_BAR;
    for (;;) {
        const bool has_next = S.next(ui + 1, nxt);
        const char* nA = cA; const char* nB = cB;
        if constexpr (Sched::GATHER) {
#pragma unroll
            for (int h = 0; h < 2; ++h)
#pragma unroll
                for (int i = 0; i < 2; ++i) nv[h][i] = cv[h][i];
        }
        if (has_next) { nA = S.a_base(nxt); nB = S.b_base(nxt); if constexpr (Sched::GATHER) S.a_offs(nxt, Rp, Cp, nv); }
        if (Sched::PARTIAL && cur.vr < 256) { PG8_TLOOP(PG8_MMAG) } else { PG8_TLOOP(PG8_MMA) }
        if (wr == 0) PG8_BAR;
        E(acc, cur, wr, wc, fr, fq);
        if (!has_next) break;
#pragma unroll
        for (int a = 0; a < 2; ++a)
#pragma unroll
            for (int b = 0; b < 2; ++b)
#pragma unroll
                for (int m = 0; m < 4; ++m)
#pragma unroll
                    for (int n = 0; n < 2; ++n) acc[a][b][m][n] = (f32x4){0.f, 0.f, 0.f, 0.f};
        cur = nxt; cA = nA; cB = nB; ++ui;
        PG8_SETMC(cur);
        if constexpr (Sched::GATHER) {
#pragma unroll
            for (int h = 0; h < 2; ++h)
#pragma unroll
                for (int i = 0; i < 2; ++i) cv[h][i] = nv[h][i];
        }
        if (wr == 1) PG8_BAR;
    }
    PG8_WAIT_V(0);
    PG8_BAR;
#undef PG8_SETMC
#undef PG8_TLOOP
#undef PG8_MMAG
#undef PG8_SA
#undef PG8_SB
#undef PG8_STAGE
#undef PG8_LDA
#undef PG8_LDB
#undef PG8_MMA
#undef PG8_WAIT_V
#undef PG8_WAIT_L
#undef PG8_BAR
#undef PG8_SCHED
}
}
using pg8::Unit;

struct ListEnt { int tok; int dest; float gate; float rstd; };

struct Args { const float* in[17]; float* out; unsigned char* ws; int ph_lo, ph_hi, li, pad; };

struct Frame {
    LAS unsigned char* lds;
    volatile LAS unsigned* MISC;
    unsigned* ctl;
    int tid, lane, wave, G, vcu;
    unsigned char* ws; float* out;
};
enum { I_X = 0, I_ATTN_G, I_FFN_G, I_W_IN_AB, I_W_OUT_AB, I_RET_GN, I_W_IN_C, I_B_IN_C, I_SINKS, I_W_OUT_C, I_B_OUT_C, I_W_GROUP, I_W_ER, I_W_GATE, I_W_UP, I_W_DOWN, I_FINAL_G };

__device__ __forceinline__ void transpose_tile(const float* __restrict__ W, int ldw, int k0, int nsrc0, bf16* __restrict__ WT, int ldt, int ndst0, LAS float* scr, int lane) {
#pragma unroll 8
    for (int i = 0; i < 32; ++i) { const int kk = 2 * i + (lane >> 5); scr[kk * 33 + (lane & 31)] = W[(size_t)(k0 + kk) * ldw + nsrc0 + (lane & 31)]; }
    LDS_WAIT(); asm volatile("" ::: "memory");
    const int c = lane & 7;
#pragma unroll
    for (int j = 0; j < 4; ++j) { const int n = (lane >> 3) + 8 * j; const LAS float* s = scr + (8 * c) * 33 + n;
        v4u o; o.x = cvt_pk_bf16(s[0 * 33], s[1 * 33]); o.y = cvt_pk_bf16(s[2 * 33], s[3 * 33]); o.z = cvt_pk_bf16(s[4 * 33], s[5 * 33]); o.w = cvt_pk_bf16(s[6 * 33], s[7 * 33]);
        *(v4u*)(WT + (size_t)(ndst0 + n) * ldt + k0 + 8 * c) = o; }
    LDS_WAIT(); asm volatile("" ::: "memory");
}
__device__ __forceinline__ int inproj_src_block(int pb) { const int pn = pb >> 3, t = pb & 7; return 8 * pn + 2 * (t & 3) + (t >> 2); }

__device__ __forceinline__ void convert_dense_weights(Frame& F, const Args& args) {
    LAS float* scr = (LAS float*)(F.lds + F.wave * 16384);
    const int gw = F.vcu * NWAVES + F.wave, NGW = F.G * NWAVES;
    constexpr int I_A = 16 * 112, I_B = 16 * 32, I_C = 16 * 48, I_D = 16 * 32;
    for (int it = gw; it < I_A + I_B + I_C + I_D; it += NGW) {
        int r = it;
        if (r < I_A) { const int kb = r / 112, nb = r % 112; transpose_tile(args.in[I_W_IN_AB], IN_AB, 64 * kb, 32 * inproj_src_block(nb), (bf16*)(F.ws + WS_WINAB), DM, 32 * nb, scr, F.lane); continue; } r -= I_A;
        if (r < I_B) { const int kb = r / 32, nb = r % 32; transpose_tile(args.in[I_W_OUT_AB], DM, 64 * kb, 32 * nb, (bf16*)(F.ws + WS_WOUTAB), DM, 32 * nb, scr, F.lane); continue; } r -= I_B;
        if (r < I_C) { const int kb = r / 48, nb = r % 48; transpose_tile(args.in[I_W_IN_C], IN_C, 64 * kb, 32 * inproj_src_block(nb), (bf16*)(F.ws + WS_WINC), DM, 32 * nb, scr, F.lane); continue; } r -= I_C;
        { const int kb = r / 32, nb = r % 32; transpose_tile(args.in[I_W_OUT_C], DM, 64 * kb, 32 * nb, (bf16*)(F.ws + WS_WOUTC), DM, 32 * nb, scr, F.lane); }
    }
}
__device__ __forceinline__ void convert_moe_weights(Frame& F, const Args& args, int layer) {
    LAS float* scr = (LAS float*)(F.lds + F.wave * 16384);
    const int gw = F.vcu * NWAVES + F.wave, NGW = F.G * NWAVES;
    const float* Wg = args.in[I_W_GATE] + (size_t)layer * NEXP * DM * DEXP;
    const float* Wu = args.in[I_W_UP] + (size_t)layer * NEXP * DM * DEXP;
    const float* Wd = args.in[I_W_DOWN] + (size_t)layer * NEXP * DEXP * DM;
    bf16* WGU = (bf16*)(F.ws + WS_WGU); bf16* WD = (bf16*)(F.ws + WS_WD);
    constexpr int PER_E = 16 * 32 + 8 * 32;
    for (int it = gw; it < NEXP * PER_E; it += NGW) {
        const int e = it / PER_E; int r = it % PER_E;
        if (r < 512) { const int kb = r / 32, nb = r % 32; const int pn = nb >> 3, s = (nb >> 2) & 1, jb = nb & 3;
            transpose_tile((s ? Wu : Wg) + (size_t)e * DM * DEXP, DEXP, 64 * kb, 32 * (4 * pn + jb), WGU + (size_t)e * 1024 * DM, DM, 32 * nb, scr, F.lane); }
        else { r -= 512; const int kb = r / 32, nb = r % 32;
            transpose_tile(Wd + (size_t)e * DEXP * DM, DM, 64 * kb, 32 * nb, WD + (size_t)e * DM * DEXP, DEXP, 32 * nb, scr, F.lane); }
    }
}
__device__ const double INVF[32] = {1.0, 0.7498942093324559, 0.5623413251903491, 0.4216965034285822, 0.31622776601683794, 0.23713737056616552, 0.1778279410038923, 0.1333521432163324, 0.09999999999999999, 0.07498942093324558, 0.056234132519034905, 0.042169650342858224, 0.03162277660168379, 0.023713737056616554, 0.01778279410038923, 0.013335214321633239, 0.01, 0.007498942093324559, 0.005623413251903491, 0.004216965034285822, 0.0031622776601683794, 0.002371373705661655, 0.0017782794100389228, 0.0013335214321633238, 0.001, 0.0007498942093324559, 0.000562341325190349, 0.00042169650342858224, 0.00031622776601683794, 0.00023713737056616554, 0.0001778279410038923, 0.0001333521432163324};
__device__ const float LG2G[8] = {-0.04580368961312479f, -0.02272007650008353f, -0.011315313227834146f, -0.005646563141142062f, -0.0028205190623786626f, -0.0014095702546713534f, -0.0007046129765893727f, -0.0003522634716290214f};
__device__ __forceinline__ void build_tables(Frame& F) {
    float* cosT = (float*)(F.ws + WS_COS); float* sinT = (float*)(F.ws + WS_SIN); float* gq = (float*)(F.ws + WS_GQ); float* gk = (float*)(F.ws + WS_GK);
    const int gt = F.vcu * NTHR + F.tid, NT = F.G * NTHR;
    for (int i = gt; i < SEQ * 32; i += NT) {
        const int t = i >> 5, f = i & 31;
        const double x = (double)t * INVF[f];
        const double n = __builtin_rint(x * 0.6366197723675814);
        double r = __builtin_fma(-n, 1.5707963267948966, x); r = __builtin_fma(-n, 6.123233995736766e-17, r);
        const float rf = (float)r, r2 = rf * rf;
        const float sp = rf + rf * r2 * (-1.6666667e-1f + r2 * (8.3333333e-3f + r2 * (-1.9841270e-4f + r2 * 2.7557319e-6f)));
        const float cp = 1.0f + r2 * (-0.5f + r2 * (4.1666668e-2f + r2 * (-1.3888889e-3f + r2 * 2.4801587e-5f)));
        const int q = ((int)n) & 3;
        float s = (q & 1) ? cp : sp, c = (q & 1) ? sp : cp;
        if (q == 1 || q == 2) c = -c;
        if (q >= 2) s = -s;
        cosT[i] = c; sinT[i] = s;
    }
    for (int i = gt; i < 8 * 128; i += NT) { const int h = i >> 7, p = i & 127; gq[i] = exp2f((float)p * LG2G[h]); gk[i] = exp2f(-(float)p * LG2G[h]) * 0.125f; }
}

template <int MODE>
__device__ __forceinline__ void norm_rows(Frame& F, const float* src, float* hbuf, const float* g) {
    const int gw = F.vcu * NWAVES + F.wave, NGW = F.G * NWAVES;
    float* rstd = (float*)(F.ws + WS_RSTD); bf16* hn = (bf16*)(F.ws + WS_HN);
    const bf16* y0 = (const bf16*)(F.ws + WS_Y); const bf16* y1 = y0 + (size_t)YROWS * DM;
    f32x4 gg[4];
#pragma unroll
    for (int j = 0; j < 4; ++j) gg[j] = *((const f32x4*)g + F.lane + 64 * j);
    for (int m = gw; m < NTOK; m += NGW) {
        const f32x4* xr = (const f32x4*)((MODE == 0 ? src : hbuf) + (size_t)m * DM) + F.lane;
        f32x4 v[4]; float s = 0.f;
#pragma unroll
        for (int j = 0; j < 4; ++j) v[j] = xr[64 * j];
        if (MODE != 0) {
#pragma unroll
            for (int j = 0; j < 4; ++j) { const v2u a = *((const v2u*)(y0 + (size_t)m * DM) + F.lane + 64 * j); const v2u b = *((const v2u*)(y1 + (size_t)m * DM) + F.lane + 64 * j);
                v[j][0] += bflo(a.x) + bflo(b.x); v[j][1] += bfhi(a.x) + bfhi(b.x); v[j][2] += bflo(a.y) + bflo(b.y); v[j][3] += bfhi(a.y) + bfhi(b.y); }
        }
#pragma unroll
        for (int j = 0; j < 4; ++j) s += (v[j][0] * v[j][0] + v[j][1] * v[j][1]) + (v[j][2] * v[j][2] + v[j][3] * v[j][3]);
        const float rs = 1.0f / sqrtf(wave_sum(s) * (1.0f / DM) + EPS);
        if (MODE == 2) {
            f32x4* o = (f32x4*)(hbuf + (size_t)m * DM) + F.lane;
#pragma unroll
            for (int j = 0; j < 4; ++j) o[64 * j] = v[j] * rs * gg[j];
        } else {
            if (MODE == 1) { f32x4* o = (f32x4*)(hbuf + (size_t)m * DM) + F.lane;
#pragma unroll
                for (int j = 0; j < 4; ++j) o[64 * j] = v[j]; }
            if (F.lane == 0) rstd[m] = rs;
            v2u* o8 = (v2u*)(hn + (size_t)m * DM) + F.lane;
#pragma unroll
            for (int j = 0; j < 4; ++j) { const f32x4 w = v[j] * gg[j]; v2u p; p.x = cvt_pk_bf16(w[0], w[1]); p.y = cvt_pk_bf16(w[2], w[3]); o8[64 * j] = p; }
        }
    }
}

constexpr size_t WS_RIMG = 512 * 1024;
__device__ __forceinline__ void build_router_image(Frame& F, const Args& args) {
    v4u* img = (v4u*)(F.ws + WS_RIMG);
    const int gt = F.vcu * NTHR + F.tid, NT = F.G * NTHR;
    for (int it = gt; it < 2 * 32 * 3 * 64; it += NT) {
        const int lane = it & 63, ct = (it >> 6) % 3, ks = (it / 192) & 31, layer = it / (192 * 32);
        const int r16 = lane & 15, q = lane >> 4;
        const float* wer = args.in[I_W_ER] + (size_t)layer * DM * 32; const float* wg = args.in[I_W_GROUP] + (size_t)layer * DM * 4;
        v4u hp, lp;
#pragma unroll
        for (int p = 0; p < 4; ++p) {
            const int k = 32 * ks + 8 * q + 2 * p;
            float v0, v1;
            if (ct < 2) { v0 = wer[(size_t)k * 32 + 16 * ct + r16]; v1 = wer[(size_t)(k + 1) * 32 + 16 * ct + r16]; }
            else { v0 = r16 < 4 ? wg[(size_t)k * 4 + r16] : 0.f; v1 = r16 < 4 ? wg[(size_t)(k + 1) * 4 + r16] : 0.f; }
            const unsigned h2 = cvt_pk_bf16(v0, v1); hp[p] = h2; lp[p] = cvt_pk_bf16(v0 - bflo(h2), v1 - bfhi(h2));
        }
        img[((size_t)((layer * 32 + ks) * 3 + ct) * 2 + 0) * 64 + lane] = hp;
        img[((size_t)((layer * 32 + ks) * 3 + ct) * 2 + 1) * 64 + lane] = lp;
    }
}
__device__ __forceinline__ void norm_router(Frame& F, const float* hbuf, const float* g, const v4u* rimg, unsigned* gcnt) {
    float* rstd = (float*)(F.ws + WS_RSTD); bf16* hn = (bf16*)(F.ws + WS_HN); ListEnt* list = (ListEnt*)(F.ws + WS_LIST);
    LAS float* gs = (LAS float*)(F.lds);
    LAS float* lgw = (LAS float*)(F.lds + 4096) + F.wave * 768;
    LAS int* lcnt = (LAS int*)(F.lds + 4096 + 24576);
    LAS int* lbase = lcnt + 32;
    const int l = F.lane, w = F.wave, r16 = l & 15, q = l >> 4;
    for (int i = F.tid; i < DM; i += NTHR) gs[i] = g[i];
    if (F.tid < 32) lcnt[F.tid] = 0;
    __syncthreads();
    for (int tile = F.vcu; tile < NTOK / 128; tile += F.G) {
        const int row = tile * 128 + w * 16 + r16;
        const float* hr = hbuf + (size_t)row * DM + 8 * q;
        bf16* hnr = hn + (size_t)row * DM + 8 * q;
        f32x4 acc[3] = {(f32x4){0.f, 0.f, 0.f, 0.f}, (f32x4){0.f, 0.f, 0.f, 0.f}, (f32x4){0.f, 0.f, 0.f, 0.f}};
        float ss = 0.f;
#pragma unroll 4
        for (int ks = 0; ks < 32; ++ks) {
            const f32x4 va = *(const f32x4*)(hr + 32 * ks), vb = *(const f32x4*)(hr + 32 * ks + 4);
            const f32x4 ga = *(const LAS f32x4*)(gs + 32 * ks + 8 * q), gb = *(const LAS f32x4*)(gs + 32 * ks + 8 * q + 4);
            ss += (va[0] * va[0] + va[1] * va[1]) + (va[2] * va[2] + va[3] * va[3]) + (vb[0] * vb[0] + vb[1] * vb[1]) + (vb[2] * vb[2] + vb[3] * vb[3]);
            const f32x4 xa = va * ga, xb = vb * gb;
            v4u hp, lp;
            hp.x = cvt_pk_bf16(xa[0], xa[1]); hp.y = cvt_pk_bf16(xa[2], xa[3]); hp.z = cvt_pk_bf16(xb[0], xb[1]); hp.w = cvt_pk_bf16(xb[2], xb[3]);
            lp.x = cvt_pk_bf16(xa[0] - bflo(hp.x), xa[1] - bfhi(hp.x)); lp.y = cvt_pk_bf16(xa[2] - bflo(hp.y), xa[3] - bfhi(hp.y));
            lp.z = cvt_pk_bf16(xb[0] - bflo(hp.z), xb[1] - bfhi(hp.z)); lp.w = cvt_pk_bf16(xb[2] - bflo(hp.w), xb[3] - bfhi(hp.w));
            *(v4u*)(hnr + 32 * ks) = hp;
            const bf16x8 ah = __builtin_bit_cast(bf16x8, hp), al = __builtin_bit_cast(bf16x8, lp);
            const v4u* bp = rimg + (size_t)(ks * 6) * 64 + l;
#pragma unroll
            for (int ct = 0; ct < 3; ++ct) {
                const bf16x8 bh = __builtin_bit_cast(bf16x8, bp[(2 * ct) * 64]), bl = __builtin_bit_cast(bf16x8, bp[(2 * ct + 1) * 64]);
                acc[ct] = __builtin_amdgcn_mfma_f32_16x16x32_bf16(ah, bh, acc[ct], 0, 0, 0);
                acc[ct] = __builtin_amdgcn_mfma_f32_16x16x32_bf16(al, bh, acc[ct], 0, 0, 0);
                acc[ct] = __builtin_amdgcn_mfma_f32_16x16x32_bf16(ah, bl, acc[ct], 0, 0, 0);
            }
        }
        ss += __shfl_xor(ss, 16); ss += __shfl_xor(ss, 32);
#pragma unroll
        for (int ct = 0; ct < 3; ++ct)
#pragma unroll
            for (int i = 0; i < 4; ++i) lgw[(4 * q + i) * 48 + ct * 16 + r16] = acc[ct][i];
        __syncthreads();
        int e1 = 0, e2 = 0, k1 = 0, k2 = 0; float g1 = 0.f, g2 = 0.f, rs = 0.f;
        if (l < 16) {
            rs = 1.0f / sqrtf(ss * (1.0f / DM) + EPS);
            float gl4[4];
#pragma unroll
            for (int c = 0; c < 4; ++c) gl4[c] = lgw[l * 48 + 32 + c] * rs;
            int gi = 0; float gm = gl4[0];
#pragma unroll
            for (int c = 1; c < 4; ++c) if (gl4[c] > gm) { gm = gl4[c]; gi = c; }
            float gden = 0.f;
#pragma unroll
            for (int c = 0; c < 4; ++c) gden += __expf(gl4[c] - gm);
            const float gprob = 1.0f / gden;
            float el[8];
#pragma unroll
            for (int c = 0; c < 8; ++c) el[c] = lgw[l * 48 + 8 * gi + c] * rs;
            int i1 = 0; float m1 = el[0];
#pragma unroll
            for (int c = 1; c < 8; ++c) if (el[c] > m1) { m1 = el[c]; i1 = c; }
            int i2 = 0; float m2 = -INFINITY;
#pragma unroll
            for (int c = 0; c < 8; ++c) if (c != i1 && el[c] > m2) { m2 = el[c]; i2 = c; }
            const float p2 = __expf(m2 - m1);
            const float inv = 1.0f / (1.0f + p2);
            g1 = gprob * inv; g2 = gprob * p2 * inv;
            e1 = 8 * gi + i1; e2 = 8 * gi + i2;
            rstd[row] = rs;
            k1 = atomicAdd((int*)&lcnt[e1], 1); k2 = atomicAdd((int*)&lcnt[e2], 1);
        }
        __syncthreads();
        if (F.tid < 32) { const int c = lcnt[F.tid]; int b = 0; if (c > 0) b = (int)__hip_atomic_fetch_add(gcnt + F.tid, (unsigned)c, __ATOMIC_RELAXED, __HIP_MEMORY_SCOPE_AGENT); lbase[F.tid] = b; lcnt[F.tid] = 0; }
        __syncthreads();
        if (l < 16) {
            const int s1 = lbase[e1] + k1, s2 = lbase[e2] + k2;
            ListEnt a; a.tok = row; a.dest = row; a.gate = g1; a.rstd = rs; list[(size_t)e1 * LISTCAP + s1] = a;
            ListEnt b; b.tok = row; b.dest = YROWS + row; b.gate = g2; b.rstd = rs; list[(size_t)e2 * LISTCAP + s2] = b;
        }
        __syncthreads();
    }
}

struct EpiInAB {
    static constexpr bool PERM = true;
    bf16* O; const float* rstd; const float* cosT; const float* sinT; const float* gq; const float* gk;
    __device__ __forceinline__ void operator()(const f32x4 (&acc)[2][2][4][2], const Unit& u, int wr, int wc, int fr, int fq) const {
        const int sec = u.pn >> 1, hh = 4 * (u.pn & 1) + wc;
        const int col0 = u.pn * 256 + 64 * wc + 8 * fq;
#pragma unroll
        for (int ai = 0; ai < 2; ++ai)
#pragma unroll
            for (int m = 0; m < 4; ++m) {
                const int row = u.pm * 256 + ai * 128 + wr * 64 + m * 16 + fr;
                const int t = row & (SEQ - 1);
                float mul = rstd[row];
                if (sec == 0) mul *= QSC;
                else if (sec == 3) mul *= gq[hh * 128 + (t & 127)];
                else if (sec == 4) mul *= gk[hh * 128 + (t & 127)];
                f32x4 x1[2], x2[2];
#pragma unroll
                for (int n = 0; n < 2; ++n) { x1[n] = acc[ai][0][m][n] * mul; x2[n] = acc[ai][1][m][n] * mul; }
                if (sec == 3 || sec == 4) {
#pragma unroll
                    for (int n = 0; n < 2; ++n) { const f32x4 c = *(const f32x4*)(cosT + t * 32 + 8 * fq + 4 * n), s = *(const f32x4*)(sinT + t * 32 + 8 * fq + 4 * n);
                        const f32x4 o1 = x1[n] * c - x2[n] * s, o2 = x2[n] * c + x1[n] * s; x1[n] = o1; x2[n] = o2; }
                }
                if (sec == 6) {
#pragma unroll
                    for (int n = 0; n < 2; ++n)
#pragma unroll
                        for (int i = 0; i < 4; ++i) { x1[n][i] = x1[n][i] * frcp(1.0f + fexp2(-LOG2E * x1[n][i])); x2[n][i] = x2[n][i] * frcp(1.0f + fexp2(-LOG2E * x2[n][i])); }
                }
                bf16* rp = O + (size_t)row * IN_AB + col0;
                *(v4u*)(rp) = pack8(x1[0], x1[1]); *(v4u*)(rp + 32) = pack8(x2[0], x2[1]);
                asm volatile("" ::: "memory");
            }
    }
};
struct EpiInC {
    static constexpr bool PERM = true;
    bf16* O; const float* rstd; const float* cosT; const float* sinT; const float* bias;
    __device__ __forceinline__ void operator()(const f32x4 (&acc)[2][2][4][2], const Unit& u, int wr, int wc, int fr, int fq) const {
        const int col0 = u.pn * 256 + 64 * wc + 8 * fq;
        f32x4 b1[2], b2[2];
#pragma unroll
        for (int n = 0; n < 2; ++n) { b1[n] = *(const f32x4*)(bias + col0 + 4 * n); b2[n] = *(const f32x4*)(bias + col0 + 32 + 4 * n); }
#pragma unroll
        for (int ai = 0; ai < 2; ++ai)
#pragma unroll
            for (int m = 0; m < 4; ++m) {
                const int row = u.pm * 256 + ai * 128 + wr * 64 + m * 16 + fr;
                const int t = row & (SEQ - 1);
                const float rs = rstd[row];
                f32x4 x1[2], x2[2];
#pragma unroll
                for (int n = 0; n < 2; ++n) { x1[n] = acc[ai][0][m][n] * rs + b1[n]; x2[n] = acc[ai][1][m][n] * rs + b2[n]; }
                if (u.pn < 5) {
                    const float sc = u.pn < 4 ? QSC : 1.0f;
#pragma unroll
                    for (int n = 0; n < 2; ++n) { const f32x4 c = *(const f32x4*)(cosT + t * 32 + 8 * fq + 4 * n), s = *(const f32x4*)(sinT + t * 32 + 8 * fq + 4 * n);
                        const f32x4 o1 = (x1[n] * c - x2[n] * s) * sc, o2 = (x2[n] * c + x1[n] * s) * sc; x1[n] = o1; x2[n] = o2; }
                }
                bf16* rp = O + (size_t)row * IN_C + col0;
                *(v4u*)(rp) = pack8(x1[0], x1[1]); *(v4u*)(rp + 32) = pack8(x2[0], x2[1]);
                asm volatile("" ::: "memory");
            }
    }
};
struct EpiOut {
    static constexpr bool PERM = false;
    const float* base; float* out; const float* bias;
    __device__ __forceinline__ void operator()(const f32x4 (&acc)[2][2][4][2], const Unit& u, int wr, int wc, int fr, int fq) const {
        const int col0 = u.pn * 256 + wc * 32 + 4 * fq;
        f32x4 bv[2][2];
#pragma unroll
        for (int bj = 0; bj < 2; ++bj)
#pragma unroll
            for (int n = 0; n < 2; ++n) bv[bj][n] = bias ? *(const f32x4*)(bias + col0 + bj * 128 + n * 16) : (f32x4){0.f, 0.f, 0.f, 0.f};
#pragma unroll
        for (int ai = 0; ai < 2; ++ai)
#pragma unroll
            for (int m = 0; m < 4; ++m) {
                const size_t off = (size_t)(u.pm * 256 + ai * 128 + wr * 64 + m * 16 + fr) * DM + col0;
#pragma unroll
                for (int bj = 0; bj < 2; ++bj)
#pragma unroll
                    for (int n = 0; n < 2; ++n) { const f32x4 b = *(const f32x4*)(base + off + bj * 128 + n * 16); *(f32x4*)(out + off + bj * 128 + n * 16) = b + acc[ai][bj][m][n] + bv[bj][n]; }
                if (m & 1) asm volatile("" ::: "memory");
            }
    }
};
struct EpiGateUp {
    static constexpr bool PERM = true;
    bf16* H; const ListEnt* list;
    __device__ __forceinline__ void operator()(const f32x4 (&acc)[2][2][4][2], const Unit& u, int wr, int wc, int fr, int fq) const {
        const int col0 = u.pn * 128 + 32 * wc + 8 * fq;
#pragma unroll
        for (int ai = 0; ai < 2; ++ai)
#pragma unroll
            for (int m = 0; m < 4; ++m) {
                const int rl = ai * 128 + wr * 64 + m * 16 + fr, r = u.rt0 + rl;
                const float rs = r < u.cnt ? list[(size_t)u.e * LISTCAP + r].rstd : 0.f;
                f32x4 o[2];
#pragma unroll
                for (int n = 0; n < 2; ++n)
#pragma unroll
                    for (int i = 0; i < 4; ++i) { const float gv = acc[ai][0][m][n][i] * rs, uv = acc[ai][1][m][n][i] * rs; o[n][i] = gv * uv * frcp(1.0f + fexp2(-LOG2E * gv)); }
                *(v4u*)(H + (size_t)(u.pm * 256 + rl) * DEXP + col0) = pack8(o[0], o[1]);
                asm volatile("" ::: "memory");
            }
    }
};
struct EpiDown {
    static constexpr bool PERM = true;
    bf16* Y; const ListEnt* list;
    __device__ __forceinline__ void operator()(const f32x4 (&acc)[2][2][4][2], const Unit& u, int wr, int wc, int fr, int fq) const {
        const int col0 = u.pn * 256 + 32 * wc + 8 * fq;
#pragma unroll
        for (int ai = 0; ai < 2; ++ai)
#pragma unroll
            for (int m = 0; m < 4; ++m) {
                const int r = u.rt0 + ai * 128 + wr * 64 + m * 16 + fr;
                int dest = NTOK; float gt = 0.f;
                if (r < u.cnt) { const ListEnt en = list[(size_t)u.e * LISTCAP + r]; dest = en.dest; gt = en.gate; }
                bf16* rp = Y + (size_t)dest * DM + col0;
#pragma unroll
                for (int bj = 0; bj < 2; ++bj) *(v4u*)(rp + bj * 128) = pack8(acc[ai][bj][m][0] * gt, acc[ai][bj][m][1] * gt);
                asm volatile("" ::: "memory");
            }
    }
};
constexpr int TL_OFF = RING_BYTES + 512;
template <bool GATHER_> struct MoeOrder {
    static constexpr bool GATHER = GATHER_, gather = GATHER_, PARTIAL = false;
    const LAS int* tp; const LAS int* cl; const LAS unsigned* tl; int total, G, c, K;
    const char* A; const char* Bt; const ListEnt* list; size_t bstride;
    __device__ __forceinline__ bool next(int i, Unit& u) const {
        const int L = i * G + c, T = L >> 2; if (T >= total) return false;
        const unsigned en = (unsigned)__builtin_amdgcn_readfirstlane((int)tl[T]);
        const int e = en & 31, rt = (en >> 5) & 127;
        u.e = e; u.pm = tp[e] + rt; u.rt0 = rt * 256; u.cnt = cl[e]; u.vr = (int)(en >> 12); u.pn = L & 3; return true;
    }
    __device__ __forceinline__ const char* a_base(const Unit& u) const { return gather ? A : A + (size_t)u.pm * ((size_t)256 * K * 2); }
    __device__ __forceinline__ const char* b_base(const Unit& u) const { return Bt + (size_t)u.e * bstride + (size_t)u.pn * ((size_t)256 * K * 2); }
    __device__ __forceinline__ void a_offs(const Unit& u, const int (&Rp)[2], const int (&Cp)[2], unsigned (&v)[2][2]) const {
#pragma unroll
        for (int h = 0; h < 2; ++h)
#pragma unroll
            for (int i = 0; i < 2; ++i) {
                if (gather) { const int r = u.rt0 + h * 128 + Rp[i]; int tok = 0; if (r < u.cnt) tok = list[(size_t)u.e * LISTCAP + r].tok; v[h][i] = (unsigned)((tok * K + Cp[i]) * 2); }
                else v[h][i] = (unsigned)(((h * 128 + Rp[i]) * K + Cp[i]) * 2);
            }
    }
};
__device__ __forceinline__ void moe_tables(Frame& F, const unsigned* gcnt) {
    volatile LAS unsigned* TL = (volatile LAS unsigned*)(F.lds + TL_OFF);
    if (F.tid < 64) {
        const int e = F.tid;
        int c = 0; if (e < 32) c = (int)__hip_atomic_load(gcnt + e, __ATOMIC_RELAXED, __HIP_MEMORY_SCOPE_AGENT);
        const int nt = (c + 255) >> 8, nfull = c >> 8, rem = c & 255;
        const int cls = rem == 0 ? 0 : (rem > 128 ? 1 : (rem > 64 ? 2 : 3));
        int inc = nt, incf = nfull;
#pragma unroll
        for (int o = 1; o < 32; o <<= 1) { const int v = __shfl_up(inc, o), vf = __shfl_up(incf, o); if (e >= o) { inc += v; incf += vf; } }
        const int total = __shfl(inc, 31), totf = __shfl(incf, 31);
        const unsigned long long b1 = __ballot(e < 32 && cls == 1), b2 = __ballot(e < 32 && cls == 2), b3 = __ballot(e < 32 && cls == 3);
        const unsigned long long lt = (1ull << e) - 1ull;
        if (e < 32) {
            F.MISC[16 + e] = (unsigned)(inc - nt); F.MISC[64 + e] = (unsigned)c; if (e == 31) F.MISC[48] = (unsigned)total;
            const int pf = incf - nfull;
            for (int rt = 0; rt < nfull; ++rt) TL[pf + rt] = (unsigned)e | ((unsigned)rt << 5) | (256u << 12);
            if (cls) {
                int pos = totf;
                if (cls == 1) pos += __popcll(b1 & lt);
                else if (cls == 2) pos += __popcll(b1) + __popcll(b2 & lt);
                else pos += __popcll(b1) + __popcll(b2) + __popcll(b3 & lt);
                TL[pos] = (unsigned)e | ((unsigned)nfull << 5) | ((unsigned)rem << 12);
            }
        }
    }
    __syncthreads();
}

constexpr int KP = 144;
__device__ __forceinline__ int crow(int r, int hi) { return (r & 3) + 8 * (r >> 2) + 4 * hi; }
__device__ __forceinline__ s16x4 tr16(const LAS unsigned char* p) { return __builtin_bit_cast(s16x4, __builtin_amdgcn_ds_read_tr16_b64_v4i16((LAS v4i16_t*)p)); }
__device__ __forceinline__ bf16x8 trfrag(const LAS unsigned char* tile, int kv0, int c0, int lane) {
    const int hi = lane >> 5; const LAS unsigned char* p = tile + (kv0 + 4 * hi + ((lane & 15) >> 2)) * KP + (c0 + 16 * ((lane >> 4) & 1) + 4 * (lane & 3)) * 2;
    const s16x4 a = tr16(p), b = tr16(p + 8 * KP);
    return (bf16x8){a[0], a[1], a[2], a[3], b[0], b[1], b[2], b[3]};
}
__device__ __forceinline__ bf16x8 rowfrag(const LAS unsigned char* tile, int row, int c0) { return *(const LAS bf16x8*)(tile + row * KP + c0 * 2); }
__device__ __forceinline__ float swap_other(float v, int hi, float& prod) {
    auto rr = __builtin_amdgcn_permlane32_swap(__float_as_uint(v), __float_as_uint(v), false, false);
    const float lo = __uint_as_float(rr[0]), hv = __uint_as_float(rr[1]); prod = lo * hv; return hi ? lo : hv;
}
__device__ __forceinline__ bf16x8 packp(const f32x16& p, int b) {
    v4u w; w.x = cvt_pk_bf16(p[b], p[b + 1]); w.y = cvt_pk_bf16(p[b + 2], p[b + 3]); w.z = cvt_pk_bf16(p[b + 4], p[b + 5]); w.w = cvt_pk_bf16(p[b + 6], p[b + 7]); return __builtin_bit_cast(bf16x8, w);
}
__device__ __forceinline__ void store_ot(bf16* rowp, const f32x16& o0, const f32x16& o1, int hi) {
#pragma unroll
    for (int g = 0; g < 4; ++g) {
        v2u a; a.x = cvt_pk_bf16(o0[4 * g], o0[4 * g + 1]); a.y = cvt_pk_bf16(o0[4 * g + 2], o0[4 * g + 3]); *(v2u*)(rowp + 8 * g + 4 * hi) = a;
        v2u b; b.x = cvt_pk_bf16(o1[4 * g], o1[4 * g + 1]); b.y = cvt_pk_bf16(o1[4 * g + 2], o1[4 * g + 3]); *(v2u*)(rowp + 32 + 8 * g + 4 * hi) = b;
    }
}

constexpr float SB_DONE = 1e-13f;
__device__ __forceinline__ void sb_unit(Frame& F, int b, int h, int qb) {
    const bf16* proj = (const bf16*)(F.ws + WS_PROJ); bf16* cat = (bf16*)(F.ws + WS_CAT);
    LAS unsigned char* Kb = F.lds; LAS unsigned char* Vb = F.lds + 2 * 64 * KP; volatile LAS int* flags = (volatile LAS int*)(F.lds + 4 * 64 * KP);
    const int lane = F.lane, w = F.wave, r32 = lane & 31, hi = lane >> 5;
    const size_t rowbase = (size_t)b * SEQ;
    const int q0 = qb * 256 + 32 * w;
    const bf16* qrow = proj + (rowbase + q0 + r32) * IN_AB + 64 * h;
    bf16x8 qr[4];
#pragma unroll
    for (int d0 = 0; d0 < 4; ++d0) qr[d0] = *(const bf16x8*)(qrow + 16 * d0 + 8 * hi);
    const int lrow = F.tid >> 3, lch = F.tid & 7;
    const bf16* kg = proj + (rowbase + lrow) * IN_AB + 512 + 64 * h + 8 * lch;
    const bf16* vg = proj + (rowbase + lrow) * IN_AB + 1024 + 64 * h + 8 * lch;
    const int ldst = lrow * KP + lch * 16;
    const int Ttop = 4 * qb + 3;
    v4u kreg = *(const v4u*)(kg + (size_t)(64 * Ttop) * IN_AB), vreg = *(const v4u*)(vg + (size_t)(64 * Ttop) * IN_AB);
    if (lane == 0) flags[w] = 0;
    *(LAS v4u*)(Kb + ldst) = kreg; *(LAS v4u*)(Vb + ldst) = vreg;
    f32x16 o0 = {}, o1 = {};
    float carry = 1.0f;
    int cur = 0; bool wdone = false;
    for (int T = Ttop; T >= 0; --T) {
        __syncthreads();
        { int alld = 1;
#pragma unroll
          for (int j = 0; j < 8; ++j) alld &= flags[j];
          if (alld) break; }
        if (T > 0) { kreg = *(const v4u*)(kg + (size_t)(64 * (T - 1)) * IN_AB); vreg = *(const v4u*)(vg + (size_t)(64 * (T - 1)) * IN_AB); }
        const int Trel = T - 4 * qb;
        const bool active = (Trel <= (w >> 1)) && !wdone;
        if (active) {
            const LAS unsigned char* Kt = Kb + cur * 64 * KP; const LAS unsigned char* Vt = Vb + cur * 64 * KP;
            f32x16 p0 = {}, p1 = {};
#pragma unroll
            for (int d0 = 0; d0 < 4; ++d0) {
                const bf16x8 k0 = rowfrag(Kt, r32, 16 * d0 + 8 * hi), k1 = rowfrag(Kt, 32 + r32, 16 * d0 + 8 * hi);
                p0 = __builtin_amdgcn_mfma_f32_32x32x16_bf16(k0, qr[d0], p0, 0, 0, 0);
                p1 = __builtin_amdgcn_mfma_f32_32x32x16_bf16(k1, qr[d0], p1, 0, 0, 0);
            }
            f32x16 f0, f1;
            const bool diag = Trel == (w >> 1);
            const int qrel = 32 * w + r32, kbase = 64 * Trel;
#pragma unroll
            for (int r = 0; r < 16; ++r) {
                { const float e = fexp2(fminf(-p0[r], 80.f)); const float rc = frcp(1.0f + e); float bt = rc, ff = e * rc;
                  if (diag && (kbase + crow(r, hi) >= qrel)) { bt = 0.f; ff = 1.f; } p0[r] = bt; f0[r] = ff; }
                { const float e = fexp2(fminf(-p1[r], 80.f)); const float rc = frcp(1.0f + e); float bt = rc, ff = e * rc;
                  if (diag && (kbase + 32 + crow(r, hi) >= qrel)) { bt = 0.f; ff = 1.f; } p1[r] = bt; f1[r] = ff; }
            }
            float later[8], oth[8];
            { float Tg[8];
#pragma unroll
              for (int g = 0; g < 4; ++g) { const float Fa = (f0[4 * g] * f0[4 * g + 1]) * (f0[4 * g + 2] * f0[4 * g + 3]); oth[g] = swap_other(Fa, hi, Tg[g]);
                                           const float Fb = (f1[4 * g] * f1[4 * g + 1]) * (f1[4 * g + 2] * f1[4 * g + 3]); oth[4 + g] = swap_other(Fb, hi, Tg[4 + g]); }
              float run = carry;
#pragma unroll
              for (int idx = 7; idx >= 0; --idx) { later[idx] = run; run *= Tg[idx]; }
              carry = run; }
#pragma unroll
            for (int g = 0; g < 4; ++g) {
                { const float gf = later[g] * (hi ? 1.0f : oth[g]); const float s2 = f0[4 * g + 3], s1 = f0[4 * g + 2] * s2, s0 = f0[4 * g + 1] * s1;
                  p0[4 * g] *= s0 * gf; p0[4 * g + 1] *= s1 * gf; p0[4 * g + 2] *= s2 * gf; p0[4 * g + 3] *= gf; }
                { const float gf = later[4 + g] * (hi ? 1.0f : oth[4 + g]); const float s2 = f1[4 * g + 3], s1 = f1[4 * g + 2] * s2, s0 = f1[4 * g + 1] * s1;
                  p1[4 * g] *= s0 * gf; p1[4 * g + 1] *= s1 * gf; p1[4 * g + 2] *= s2 * gf; p1[4 * g + 3] *= gf; }
            }
            const bf16x8 pf0 = packp(p0, 0), pf1 = packp(p0, 8), pf2 = packp(p1, 0), pf3 = packp(p1, 8);
            o0 = __builtin_amdgcn_mfma_f32_32x32x16_bf16(trfrag(Vt, 0, 0, lane), pf0, o0, 0, 0, 0);
            o1 = __builtin_amdgcn_mfma_f32_32x32x16_bf16(trfrag(Vt, 0, 32, lane), pf0, o1, 0, 0, 0);
            o0 = __builtin_amdgcn_mfma_f32_32x32x16_bf16(trfrag(Vt, 16, 0, lane), pf1, o0, 0, 0, 0);
            o1 = __builtin_amdgcn_mfma_f32_32x32x16_bf16(trfrag(Vt, 16, 32, lane), pf1, o1, 0, 0, 0);
            o0 = __builtin_amdgcn_mfma_f32_32x32x16_bf16(trfrag(Vt, 32, 0, lane), pf2, o0, 0, 0, 0);
            o1 = __builtin_amdgcn_mfma_f32_32x32x16_bf16(trfrag(Vt, 32, 32, lane), pf2, o1, 0, 0, 0);
            o0 = __builtin_amdgcn_mfma_f32_32x32x16_bf16(trfrag(Vt, 48, 0, lane), pf3, o0, 0, 0, 0);
            o1 = __builtin_amdgcn_mfma_f32_32x32x16_bf16(trfrag(Vt, 48, 32, lane), pf3, o1, 0, 0, 0);
            const int dn = __all(carry < SB_DONE) ? 1 : 0;
            if (lane == 0) flags[w] = dn;
            wdone = dn != 0;
        }
        if (T > 0) { *(LAS v4u*)(Kb + (cur ^ 1) * 64 * KP + ldst) = kreg; *(LAS v4u*)(Vb + (cur ^ 1) * 64 * KP + ldst) = vreg; }
        cur ^= 1;
    }
    store_ot(cat + (rowbase + q0 + r32) * DM + 64 * h, o0, o1, hi);
    __syncthreads();
}

__device__ __forceinline__ void ret_chain(Frame& F, const float* gn, int b, int h, int c_begin, int c_end) {
    const bf16* proj = (const bf16*)(F.ws + WS_PROJ); bf16* cat = (bf16*)(F.ws + WS_CAT);
    LAS unsigned char* Qs = F.lds; LAS unsigned char* Ks = F.lds + 128 * KP; LAS unsigned char* Vs = F.lds + 256 * KP; LAS unsigned char* RT = F.lds + 384 * KP;
    const int lane = F.lane, w = F.wave, r32 = lane & 31, hi = lane >> 5;
    const size_t rowbase = (size_t)b * SEQ;
    const float gam = 1.0f - exp2f(-5.0f - (float)h), g127 = exp2f(127.f * LG2G[h]), g128 = exp2f(128.f * LG2G[h]);
    const int lr0 = F.tid >> 3, lch = F.tid & 7;
    const bf16* gq_ = proj + (rowbase + lr0) * IN_AB + 1536 + 64 * h + 8 * lch;
    v4u rq[2], rk[2], rv[2];
#pragma unroll
    for (int i = 0; i < 2; ++i) { const bf16* p = gq_ + (size_t)(64 * i) * IN_AB; rq[i] = (v4u){0u, 0u, 0u, 0u}; if (c_begin == 0) rq[i] = *(const v4u*)p; rk[i] = *(const v4u*)(p + 512); rv[i] = *(const v4u*)(p + 1024); }
    f32x16 Racc = {};
    const int dt = (w >> 1) & 1, et = w & 1;
    if (w >= 4) {
#pragma unroll
        for (int g = 0; g < 4; ++g) *(LAS v2u*)(RT + (32 * et + r32) * KP + (32 * dt + 8 * g + 4 * hi) * 2) = (v2u){0u, 0u};
    }
    float gnv[2][4][4];
    if (w < 4) {
#pragma unroll
        for (int d0 = 0; d0 < 2; ++d0)
#pragma unroll
            for (int g = 0; g < 4; ++g)
#pragma unroll
                for (int i = 0; i < 4; ++i) gnv[d0][g][i] = gn[64 * h + 32 * d0 + 8 * g + 4 * hi + i];
    }
#pragma unroll 1
    for (int c = 0; c < c_end; ++c) {
        const bool full = c >= c_begin;
#pragma unroll
        for (int i = 0; i < 2; ++i) { const int o = (lr0 + 64 * i) * KP + lch * 16; if (full) *(LAS v4u*)(Qs + o) = rq[i]; *(LAS v4u*)(Ks + o) = rk[i]; *(LAS v4u*)(Vs + o) = rv[i]; }
        __syncthreads();
        if (c + 1 < c_end) {
            const bool nfull = c + 1 >= c_begin;
#pragma unroll
            for (int i = 0; i < 2; ++i) { const bf16* p = gq_ + (size_t)(128 * (c + 1) + 64 * i) * IN_AB; if (nfull) rq[i] = *(const v4u*)p; rk[i] = *(const v4u*)(p + 512); rv[i] = *(const v4u*)(p + 1024); }
        }
        const LAS unsigned char* Rc = RT + (c & 1) * 64 * KP;
        if (w < 4) {
          if (full) {
            const size_t grow = rowbase + 128 * c + 32 * w + r32;
            const bf16* gp = proj + grow * IN_AB + 3072 + 64 * h;
            v2u gv[2][4];
#pragma unroll
            for (int d0 = 0; d0 < 2; ++d0)
#pragma unroll
                for (int g = 0; g < 4; ++g) gv[d0][g] = *(const v2u*)(gp + 32 * d0 + 8 * g + 4 * hi);
            bf16x8 qr[4];
#pragma unroll
            for (int d0 = 0; d0 < 4; ++d0) qr[d0] = rowfrag(Qs, 32 * w + r32, 16 * d0 + 8 * hi);
            f32x16 o0 = {}, o1 = {};
#pragma unroll
            for (int ks = 0; ks < 4; ++ks) {
                o0 = __builtin_amdgcn_mfma_f32_32x32x16_bf16(rowfrag(Rc, r32, 16 * ks + 8 * hi), qr[ks], o0, 0, 0, 0);
                o1 = __builtin_amdgcn_mfma_f32_32x32x16_bf16(rowfrag(Rc, 32 + r32, 16 * ks + 8 * hi), qr[ks], o1, 0, 0, 0);
            }
#pragma unroll
            for (int r = 0; r < 16; ++r) { o0[r] *= gam; o1[r] *= gam; }
#pragma unroll
            for (int blk = 0; blk < 4; ++blk) {
                if (blk <= w) {
                    f32x16 p = {};
#pragma unroll
                    for (int d0 = 0; d0 < 4; ++d0) p = __builtin_amdgcn_mfma_f32_32x32x16_bf16(rowfrag(Ks, 32 * blk + r32, 16 * d0 + 8 * hi), qr[d0], p, 0, 0, 0);
                    if (blk == w) {
#pragma unroll
                        for (int r = 0; r < 16; ++r) if (crow(r, hi) > r32) p[r] = 0.f;
                    }
                    const bf16x8 pa = packp(p, 0), pb = packp(p, 8);
                    o0 = __builtin_amdgcn_mfma_f32_32x32x16_bf16(trfrag(Vs, 32 * blk, 0, lane), pa, o0, 0, 0, 0);
                    o1 = __builtin_amdgcn_mfma_f32_32x32x16_bf16(trfrag(Vs, 32 * blk, 32, lane), pa, o1, 0, 0, 0);
                    o0 = __builtin_amdgcn_mfma_f32_32x32x16_bf16(trfrag(Vs, 32 * blk + 16, 0, lane), pb, o0, 0, 0, 0);
                    o1 = __builtin_amdgcn_mfma_f32_32x32x16_bf16(trfrag(Vs, 32 * blk + 16, 32, lane), pb, o1, 0, 0, 0);
                }
            }
            float s = 0.f;
#pragma unroll
            for (int r = 0; r < 16; ++r) s += o0[r] + o1[r];
            { auto rr = __builtin_amdgcn_permlane32_swap(__float_as_uint(s), __float_as_uint(s), false, false); s = __uint_as_float(rr[0]) + __uint_as_float(rr[1]); }
            const float mu = s * (1.0f / 64.0f);
            float vs = 0.f;
#pragma unroll
            for (int r = 0; r < 16; ++r) { const float a = o0[r] - mu, bb = o1[r] - mu; vs += a * a + bb * bb; }
            { auto rr = __builtin_amdgcn_permlane32_swap(__float_as_uint(vs), __float_as_uint(vs), false, false); vs = __uint_as_float(rr[0]) + __uint_as_float(rr[1]); }
            const float rsd = 1.0f / sqrtf(vs * (1.0f / 64.0f) + EPS);
#pragma unroll
            for (int d0 = 0; d0 < 2; ++d0)
#pragma unroll
                for (int g = 0; g < 4; ++g) {
                    const v2u gvv = gv[d0][g];
                    const float sg[4] = {bflo(gvv.x), bfhi(gvv.x), bflo(gvv.y), bfhi(gvv.y)};
#pragma unroll
                    for (int i = 0; i < 4; ++i) { if (d0) o1[4 * g + i] = (o1[4 * g + i] - mu) * rsd * gnv[d0][g][i] * sg[i]; else o0[4 * g + i] = (o0[4 * g + i] - mu) * rsd * gnv[d0][g][i] * sg[i]; }
                }
            store_ot(cat + grow * DM + 512 + 64 * h, o0, o1, hi);
          }
        } else if (c + 1 < c_end) {
            f32x16 tmp = {};
#pragma unroll
            for (int ks = 0; ks < 8; ++ks) tmp = __builtin_amdgcn_mfma_f32_32x32x16_bf16(trfrag(Ks, 16 * ks, 32 * dt, lane), trfrag(Vs, 16 * ks, 32 * et, lane), tmp, 0, 0, 0);
#pragma unroll
            for (int r = 0; r < 16; ++r) Racc[r] = g128 * Racc[r] + g127 * tmp[r];
            if (c + 1 >= c_begin) {
                LAS unsigned char* Rn = RT + ((c + 1) & 1) * 64 * KP;
#pragma unroll
                for (int g = 0; g < 4; ++g) { v2u a; a.x = cvt_pk_bf16(Racc[4 * g], Racc[4 * g + 1]); a.y = cvt_pk_bf16(Racc[4 * g + 2], Racc[4 * g + 3]);
                    *(LAS v2u*)(Rn + (32 * et + r32) * KP + (32 * dt + 8 * g + 4 * hi) * 2) = a; }
            }
        }
        __syncthreads();
    }
}

__device__ __forceinline__ void swa_unit(Frame& F, const float* sinks, int b, int g, int n) {
    const bf16* proj = (const bf16*)(F.ws + WS_PROJ); bf16* cat = (bf16*)(F.ws + WS_CAT);
    LAS unsigned char* Kb = F.lds; LAS unsigned char* Vb = F.lds + 256 * KP;
    const int lane = F.lane, w = F.wave, r32 = lane & 31, hi = lane >> 5;
    const size_t rowbase = (size_t)b * SEQ;
    {
        const int lch = F.tid & 7;
#pragma unroll
        for (int i = 0; i < 4; ++i) {
            const int br = (F.tid >> 3) + 64 * i; int pos = 128 * (n - 1) + br; pos = pos < 0 ? 0 : pos;
            const bf16* p = proj + (rowbase + pos) * IN_C + 1024 + 64 * g + 8 * lch;
            *(LAS v4u*)(Kb + br * KP + lch * 16) = *(const v4u*)p; *(LAS v4u*)(Vb + br * KP + lch * 16) = *(const v4u*)(p + 256);
        }
    }
    __syncthreads();
    const int hq = 4 * g + (w >> 1);
    const float sink2 = sinks[hq] * LOG2E;
#pragma unroll 1
    for (int rg = 0; rg < 2; ++rg) {
        const int r0 = 64 * (w & 1) + 32 * rg;
        const size_t qrow = rowbase + 128 * n + r0 + r32;
        const bf16* qp = proj + qrow * IN_C + 64 * hq;
        bf16x8 qr[4];
#pragma unroll
        for (int d0 = 0; d0 < 4; ++d0) qr[d0] = *(const bf16x8*)(qp + 16 * d0 + 8 * hi);
        f32x16 s[5];
        const int blk0 = r0 >> 5;
#pragma unroll
        for (int i = 0; i < 5; ++i) {
            s[i] = (f32x16){};
#pragma unroll
            for (int d0 = 0; d0 < 4; ++d0) s[i] = __builtin_amdgcn_mfma_f32_32x32x16_bf16(rowfrag(Kb, 32 * (blk0 + i) + r32, 16 * d0 + 8 * hi), qr[d0], s[i], 0, 0, 0);
        }
        const int qi = r0 + r32;
        float m = sink2;
#pragma unroll
        for (int i = 0; i < 5; ++i)
#pragma unroll
            for (int r = 0; r < 16; ++r) { const int kb = 32 * (blk0 + i) + crow(r, hi); const int rel = qi + 128 - kb; const bool ok = (rel >= 0) && (rel < 128) && (n > 0 || kb >= 128);
                s[i][r] = ok ? s[i][r] : -INFINITY; m = fmaxf(m, s[i][r]); }
        { auto rr = __builtin_amdgcn_permlane32_swap(__float_as_uint(m), __float_as_uint(m), false, false); m = fmaxf(__uint_as_float(rr[0]), __uint_as_float(rr[1])); }
        float l = 0.f;
#pragma unroll
        for (int i = 0; i < 5; ++i)
#pragma unroll
            for (int r = 0; r < 16; ++r) { const float p = fexp2(s[i][r] - m); s[i][r] = p; l += p; }
        { auto rr = __builtin_amdgcn_permlane32_swap(__float_as_uint(l), __float_as_uint(l), false, false); l = __uint_as_float(rr[0]) + __uint_as_float(rr[1]); }
        l += fexp2(sink2 - m);
        const float il = 1.0f / l;
        f32x16 o0 = {}, o1 = {};
#pragma unroll
        for (int i = 0; i < 5; ++i) {
            const bf16x8 pa = packp(s[i], 0), pb = packp(s[i], 8);
            const int kv0 = 32 * (blk0 + i);
            o0 = __builtin_amdgcn_mfma_f32_32x32x16_bf16(trfrag(Vb, kv0, 0, lane), pa, o0, 0, 0, 0);
            o1 = __builtin_amdgcn_mfma_f32_32x32x16_bf16(trfrag(Vb, kv0, 32, lane), pa, o1, 0, 0, 0);
            o0 = __builtin_amdgcn_mfma_f32_32x32x16_bf16(trfrag(Vb, kv0 + 16, 0, lane), pb, o0, 0, 0, 0);
            o1 = __builtin_amdgcn_mfma_f32_32x32x16_bf16(trfrag(Vb, kv0 + 16, 32, lane), pb, o1, 0, 0, 0);
        }
#pragma unroll
        for (int r = 0; r < 16; ++r) { o0[r] *= il; o1[r] *= il; }
        store_ot(cat + qrow * DM + 64 * hq, o0, o1, hi);
    }
    __syncthreads();
}


#define IN(k) (lo <= (k) && (k) < hi)
#define EN(b) ((PH_MASK >> (b)) & 1)
#define SEAM(k) do { if (IN(k) && IN((k) + 1)) { XcdBarrier bb_ = bar; asm volatile("" : "+s"(bb_.bar)); xcd_barrier(bb_); } } while (0)
template <int layer>
__device__ __forceinline__ void layer_phases(Frame& F, const Args& args, const XcdBarrier& bar, const int lo, const int hi) {

        const int pb = 1 + 7 * layer;
        { unsigned char* w_ = args.ws; asm volatile("" : "+s"(w_)); F.ws = w_; F.ctl = (unsigned*)(w_ + WS_CTL); }
        float* const hbuf = F.out;
        const float* cosT = (const float*)(F.ws + WS_COS); const float* sinT = (const float*)(F.ws + WS_SIN);
        const float* gqT = (const float*)(F.ws + WS_GQ); const float* gkT = (const float*)(F.ws + WS_GK);
        const float* rstd = (const float*)(F.ws + WS_RSTD);
        const ListEnt* list = (const ListEnt*)(F.ws + WS_LIST);
        if (EN(1) && IN(pb)) {
            if (layer == 0) {
                pg8::DenseOrder S; S.init(F.ws + WS_HN, F.ws + WS_WINAB, NTOK, IN_AB, DM, F.G, (int)blockIdx.x);
                EpiInAB E{(bf16*)(F.ws + WS_PROJ), rstd, cosT, sinT, gqT, gkT};
                pg8::gemm_phase<EpiInAB, pg8::DenseOrder>(F.lds, DM, S, E);
            } else {
                pg8::DenseOrder S; S.init(F.ws + WS_HN, F.ws + WS_WINC, NTOK, IN_C, DM, F.G, (int)blockIdx.x);
                EpiInC E{(bf16*)(F.ws + WS_PROJ), rstd, cosT, sinT, args.in[I_B_IN_C]};
                pg8::gemm_phase<EpiInC, pg8::DenseOrder>(F.lds, DM, S, E);
            }
        }
        SEAM(pb);
        if (EN(2) && IN(pb + 1)) {
            if (layer == 0) {
                const int bh = F.vcu >> 1, half = F.vcu & 1;
                if (F.G == 256) {
                    if (half == 0) ret_chain(F, args.in[I_RET_GN], bh >> 3, bh & 7, 0, 8); else ret_chain(F, args.in[I_RET_GN], bh >> 3, bh & 7, 8, 16);
                    const int nsb = half == 0 ? 5 : 3;
#pragma unroll 1
                    for (int i = 0; i < nsb; ++i) { const int qb = half == 0 ? ((i == 0) ? 0 : (i == 1) ? 7 : (i == 2) ? 2 : (i == 3) ? 5 : 3) : ((i == 0) ? 1 : (i == 1) ? 6 : 4); sb_unit(F, bh >> 3, bh & 7, qb); }
                } else {
#pragma unroll 1
                    for (int u = F.vcu; u < 128; u += F.G) ret_chain(F, args.in[I_RET_GN], u >> 3, u & 7, 0, 16);
#pragma unroll 1
                    for (int u = F.vcu; u < 1024; u += F.G) sb_unit(F, u >> 6, (u >> 3) & 7, u & 7);
                }
            } else {
#pragma unroll 1
                for (int u = F.vcu; u < NB * 4 * 16; u += F.G) swa_unit(F, args.in[I_SINKS], u >> 6, (u >> 4) & 3, u & 15);
            }
        }
        SEAM(pb + 1);
        if (EN(3) && IN(pb + 2)) {
            pg8::DenseOrder S; S.init(F.ws + WS_CAT, F.ws + (layer == 0 ? WS_WOUTAB : WS_WOUTC), NTOK, DM, DM, F.G, (int)blockIdx.x);
            EpiOut E{layer == 0 ? args.in[I_X] : hbuf, hbuf, layer == 0 ? nullptr : args.in[I_B_OUT_C]};
            pg8::gemm_phase<EpiOut, pg8::DenseOrder>(F.lds, DM, S, E);
        }
        SEAM(pb + 2);
        if (EN(4) && IN(pb + 3)) {
            norm_router(F, hbuf, args.in[I_FFN_G] + layer * DM, (const v4u*)(F.ws + WS_RIMG) + (size_t)layer * 32 * 6 * 64, F.ctl + CW_CNT + 32 * layer);
        }
        SEAM(pb + 3);
        if (EN(5) && IN(pb + 4)) {
            moe_tables(F, F.ctl + CW_CNT + 32 * layer);
            MoeOrder<true> S{(const LAS int*)(F.MISC + 16), (const LAS int*)(F.MISC + 64), (const LAS unsigned*)(F.lds + TL_OFF), (int)F.MISC[48], F.G, F.vcu, DM, (const char*)(F.ws + WS_HN), (const char*)(F.ws + WS_WGU), list, (size_t)1024 * DM * 2};
            EpiGateUp E{(bf16*)(F.ws + WS_HID), list};
            pg8::gemm_phase<EpiGateUp, MoeOrder<true>>(F.lds, DM, S, E);
        }
        SEAM(pb + 4);
        if (EN(6) && IN(pb + 5)) {
            moe_tables(F, F.ctl + CW_CNT + 32 * layer);
            MoeOrder<false> S{(const LAS int*)(F.MISC + 16), (const LAS int*)(F.MISC + 64), (const LAS unsigned*)(F.lds + TL_OFF), (int)F.MISC[48], F.G, F.vcu, DEXP, (const char*)(F.ws + WS_HID), (const char*)(F.ws + WS_WD), list, (size_t)DM * DEXP * 2};
            EpiDown E{(bf16*)(F.ws + WS_Y), list};
            pg8::gemm_phase<EpiDown, MoeOrder<false>>(F.lds, DEXP, S, E);
        }
        SEAM(pb + 5);
        if (EN(7) && IN(pb + 6)) {
            if (layer == 0) { convert_moe_weights(F, args, 1); norm_rows<1>(F, nullptr, hbuf, args.in[I_ATTN_G] + DM); }
            else norm_rows<2>(F, nullptr, hbuf, args.in[I_FINAL_G]);
        }
        if (layer == 0) SEAM(pb + 6);
    }

__global__ void __launch_bounds__(NTHR, 2) mega_fwd(Args args) {
    extern __shared__ __attribute__((aligned(16))) unsigned char lds_raw[];
    Frame F;
    F.lds = (LAS unsigned char*)lds_raw;
    F.MISC = (volatile LAS unsigned*)(F.lds + MISC_OFF);
    F.tid = threadIdx.x; F.lane = F.tid & 63; F.wave = __builtin_amdgcn_readfirstlane(F.tid >> 6);
    F.G = gridDim.x; { const int bx = blockIdx.x; F.vcu = (F.G % 8 == 0) ? (bx % 8) * (F.G / 8) + bx / 8 : bx; }
    F.ws = args.ws; F.out = args.out; F.ctl = (unsigned*)(args.ws + WS_CTL);
    if (F.tid < 128) F.MISC[F.tid] = 0u;
    __syncthreads();
    XcdBarrier bar; bar.bar = F.ctl + CW_BAR + args.li * XCD_BAR_WORDS; bar.x = 0; bar.st = nullptr;
    if (!MK_SPLIT) bar = xcd_barrier_post(F.ctl + CW_BAR + args.li * XCD_BAR_WORDS, F.MISC + 8);
    const int lo = args.ph_lo, hi = args.ph_hi;

    if (EN(0) && IN(0)) {
        build_tables(F);
        build_router_image(F, args);
        convert_dense_weights(F, args);
        convert_moe_weights(F, args, 0);
        norm_rows<0>(F, args.in[I_X], nullptr, args.in[I_ATTN_G]);
    }
    SEAM(0);
    layer_phases<0>(F, args, bar, lo, hi);
    layer_phases<1>(F, args, bar, lo, hi);
#undef IN
#undef SEAM
}

extern "C" void kernel_launch(void* const* d_in, const int* in_sizes, int n_in, void* d_out, int out_size, void* d_ws, size_t ws_size, hipStream_t stream) {
    static int grid = 0;
    if (grid == 0) {
        if (n_in != 17 || out_size != NTOK * DM || ws_size < WS_END) { fprintf(stderr, "kernel_launch: unexpected shapes (n_in %d out %d ws %zu)\n", n_in, out_size, ws_size); grid = -1; return; }
        int dev = 0, cus = 0, per_cu = 0;
        if (hipGetDevice(&dev) != hipSuccess || hipDeviceGetAttribute(&cus, hipDeviceAttributeMultiprocessorCount, dev) != hipSuccess) { grid = -1; return; }
        if (hipFuncSetAttribute((const void*)mega_fwd, hipFuncAttributeMaxDynamicSharedMemorySize, LDS_BYTES) != hipSuccess) { fprintf(stderr, "kernel_launch: hipFuncSetAttribute failed\n"); grid = -1; return; }
        if (hipOccupancyMaxActiveBlocksPerMultiprocessor(&per_cu, (const void*)mega_fwd, NTHR, LDS_BYTES) != hipSuccess || per_cu < 1) { fprintf(stderr, "kernel_launch: occupancy query says %d\n", per_cu); }
        (void)hipGetLastError();
        grid = cus;
    }
    if (grid < 0) return;
    (void)hipMemsetAsync((char*)d_ws + WS_CTL, 0, CTL_ZERO_BYTES, stream);
    Args a{};
    for (int i = 0; i < 17; ++i) a.in[i] = (const float*)d_in[i];
    a.out = (float*)d_out; a.ws = (unsigned char*)d_ws;
#if MK_SPLIT
    for (int p = 0; p < 15; ++p) { a.ph_lo = p; a.ph_hi = p + 1; hipLaunchKernelGGL(mega_fwd, dim3(grid), dim3(NTHR), LDS_BYTES, stream, a); }
#elif defined(PROBE_DUP)
    { const int P = PROBE_DUP;
      a.ph_lo = 0; a.ph_hi = P + 1; a.li = 0; hipLaunchKernelGGL(mega_fwd, dim3(grid), dim3(NTHR), LDS_BYTES, stream, a);
      for (int r = 0; r < PROBE_REP; ++r) {
          if (P == 4 || P == 11) (void)hipMemsetAsync((char*)d_ws + WS_CTL + 4 * CW_CNT, 0, 256, stream);
          a.ph_lo = P; a.ph_hi = P + 1; a.li = 1; hipLaunchKernelGGL(mega_fwd, dim3(grid), dim3(NTHR), LDS_BYTES, stream, a); }
      if (P < 14) { a.ph_lo = P + 1; a.ph_hi = 15; a.li = 2; hipLaunchKernelGGL(mega_fwd, dim3(grid), dim3(NTHR), LDS_BYTES, stream, a); } }
#else
    a.ph_lo = 0; a.ph_hi = 15;
    hipLaunchKernelGGL(mega_fwd, dim3(grid), dim3(NTHR), LDS_BYTES, stream, a);
#endif
}
```
